# Optimizing an MI355X kernel written in HIP

```python
import math
import jax, jax.numpy as jnp
from jax import lax
import numpy as np

D_MODEL = 2048
BATCH = 2
SEQ = 16384
DEPTH = 1
DEC_BATCH = 32
DEC_SEQ = 64
PAST_LEN = 2048

CHUNK = 64
Q_BLOCK = 128
D_HEAD = 128
H_SB = 8
H_SA = 8
W_SB = H_SB * D_HEAD
W_SA = H_SA * D_HEAD
H_IDX = 16
D_IDX = 64
TOPK_MAX = 256
N_BUCKETS = 32
REL_MAX_DIST = 1024
D_FF = 5632
CONV_W = 3
EPS = 1e-6
IN_SIZES = (W_SB, W_SB, W_SB, W_SA, W_SA, W_SA, H_IDX * D_IDX, D_IDX, H_IDX)
IN_COLS = sum(IN_SIZES)
IN_SPLITS = tuple(int(s) for s in np.cumsum(IN_SIZES[:-1]))

kernel_name = "streaming_stickbreak_dsa_hybrid_step"


def rmsnorm(x, g):
    xf = x.astype(jnp.float32)
    y = xf * lax.rsqrt(jnp.mean(xf * xf, axis=-1, keepdims=True) + EPS)
    return (y * g.astype(jnp.float32)).astype(x.dtype)


def chunk_limit(pos):
    return (pos // CHUNK + 1) * CHUNK


def rel_bucket(rel):
    nb = N_BUCKETS // 2
    max_exact = nb // 2
    ret = jnp.where(rel > 0, nb, 0)
    n = jnp.abs(rel)
    nf = jnp.maximum(n, 1).astype(jnp.float32)
    large = max_exact + (jnp.log(nf / max_exact) / math.log(REL_MAX_DIST / max_exact)
                         * (nb - max_exact)).astype(jnp.int32)
    large = jnp.minimum(large, nb - 1)
    return ret + jnp.where(n < max_exact, n, large)


def sb_block(q, k, v, q_pos, k_pos):
    z = jnp.einsum('bqhd,bkhd->bhqk', q, k).astype(jnp.float32) * (D_HEAD ** -0.5)
    mask = k_pos[None, :] < q_pos[:, None]
    log_keep = jnp.where(mask, jax.nn.log_sigmoid(-z), 0.0)
    after = lax.cumsum(log_keep, axis=3, reverse=True) - log_keep
    a = jnp.where(mask, jnp.exp(jax.nn.log_sigmoid(z) + after), 0.0)
    return jnp.einsum('bhqk,bkhd->bqhd', a.astype(v.dtype), v)


def dsa_block(q, qi, wi, q_pos, k, v, ki, k_pos, rel_table, topk):
    lim = chunk_limit(q_pos)
    admissible = k_pos[None, :] < lim[:, None]
    s_idx = jnp.einsum('bqhe,bke->bqhk', qi, ki).astype(jnp.float32) * (D_IDX ** -0.5)
    score = jnp.einsum('bqh,bqhk->bqk', wi.astype(jnp.float32) * (H_IDX ** -0.5),
                       jax.nn.relu(s_idx))
    score = jnp.where(admissible[None], score, -jnp.inf)
    _, sel = lax.top_k(score, topk)
    sel_pos = k_pos[sel]
    valid = sel_pos < lim[None, :, None]
    bidx = jnp.arange(k.shape[0])[:, None, None]
    kg = k[bidx, sel]
    vg = v[bidx, sel]
    logits = jnp.einsum('bqhd,bqkhd->bhqk', q, kg).astype(jnp.float32) * (D_HEAD ** -0.5)
    bias = rel_table.astype(jnp.float32)[rel_bucket(sel_pos - q_pos[None, :, None])]
    logits = logits + jnp.transpose(bias, (0, 3, 1, 2))
    logits = jnp.where(valid[:, None], logits, -jnp.inf)
    p = jax.nn.softmax(logits, axis=-1)
    return jnp.einsum('bhqk,bqkhd->bqhd', p.astype(vg.dtype), vg)


def sweep(fn, qs, q_pos, kvs):
    B, Lq = qs[0].shape[:2]
    qb = min(Q_BLOCK, Lq)
    nblk = Lq // qb

    def step(args):
        b, i = args
        q_blk = tuple(lax.dynamic_slice_in_dim(a[b], i * qb, qb, axis=0)[None] for a in qs)
        kv_b = tuple(a[b][None] for a in kvs)
        pos = lax.dynamic_slice_in_dim(q_pos, i * qb, qb)
        return fn(q_blk, pos, kv_b)[0]

    bs, ib = jnp.meshgrid(jnp.arange(B), jnp.arange(nblk), indexing='ij')
    out = lax.map(step, (bs.reshape(-1), ib.reshape(-1)))
    return out.reshape((B, Lq) + out.shape[2:])


def layer(x, c, past, w_ada, b_ada, g_mix, w_in, w_gate, w_br_sb, w_br_sa, w_out,
          rel_table, g_ffn, w_up, conv_w, conv_b, w_down):
    B, L, _ = x.shape
    past_len = 0 if past is None else past[0].shape[1]
    mod = jax.nn.silu(c) @ w_ada + b_ada
    sh1, sc1, gt1, sh2, sc2, gt2 = jnp.split(mod[:, None, :], 6, axis=-1)
    h = rmsnorm(x, g_mix) * (1 + sc1) + sh1
    q_sb, k_sb, v_sb, q_sa, k_sa, v_sa, q_ix, k_ix, w_ix = jnp.split(h @ w_in, IN_SPLITS, axis=-1)
    q_sb, k_sb, v_sb = (a.reshape(B, L, H_SB, D_HEAD) for a in (q_sb, k_sb, v_sb))
    q_sa, k_sa, v_sa = (a.reshape(B, L, H_SA, D_HEAD) for a in (q_sa, k_sa, v_sa))
    q_ix = q_ix.reshape(B, L, H_IDX, D_IDX)
    if past is None:
        k_sb_all, v_sb_all, k_sa_all, v_sa_all, k_ix_all = k_sb, v_sb, k_sa, v_sa, k_ix
        prev = jnp.zeros((B, CONV_W - 1, D_FF), x.dtype)
    else:
        k_sb_all = jnp.concatenate([past[0], k_sb], axis=1)
        v_sb_all = jnp.concatenate([past[1], v_sb], axis=1)
        k_sa_all = jnp.concatenate([past[2], k_sa], axis=1)
        v_sa_all = jnp.concatenate([past[3], v_sa], axis=1)
        k_ix_all = jnp.concatenate([past[4], k_ix], axis=1)
        prev = past[5]
    l_keys = past_len + L
    k_pos = jnp.arange(l_keys, dtype=jnp.int32)
    q_pos = jnp.arange(past_len, l_keys, dtype=jnp.int32)
    topk = min(TOPK_MAX, l_keys // 4)
    o_sb = sweep(lambda q, p, kv: sb_block(q[0], kv[0], kv[1], p, k_pos),
                 (q_sb,), q_pos, (k_sb_all, v_sb_all))
    o_sa = sweep(lambda q, p, kv: dsa_block(q[0], q[1], q[2], p, kv[0], kv[1], kv[2],
                                            k_pos, rel_table, topk),
                 (q_sa, q_ix, w_ix), q_pos, (k_sa_all, v_sa_all, k_ix_all))
    g = jax.nn.sigmoid((h @ w_gate).astype(jnp.float32)).astype(x.dtype)
    g_sb, g_sa = jnp.split(g, 2, axis=-1)
    merged = (g_sb * (o_sb.reshape(B, L, W_SB) @ w_br_sb)
              + g_sa * (o_sa.reshape(B, L, W_SA) @ w_br_sa))
    x = x + gt1 * (merged @ w_out)
    h2 = rmsnorm(x, g_ffn) * (1 + sc2) + sh2
    u_g, u_v = jnp.split(h2 @ w_up, 2, axis=-1)
    ext = jnp.concatenate([prev.astype(u_g.dtype), u_g], axis=1)
    conv = conv_b + conv_w[0] * ext[:, 0:L]
    for j in range(1, CONV_W):
        conv = conv + conv_w[j] * ext[:, j:j + L]
    x = x + gt2 * ((jax.nn.silu(conv) * u_v) @ w_down)
    return x, (k_sb, v_sb, k_sa, v_sa, k_ix, ext[:, L:])


def setup_inputs(seed: int = 0) -> dict:
    key = jax.random.key(seed)
    ks = iter(jax.random.split(key, 32))

    def nrm(shape, s=1.0):
        return s * jax.random.normal(next(ks), shape, jnp.float32)

    D = D_MODEL
    return {
        "x_prompt": nrm((BATCH, SEQ, D)),
        "x_sample": nrm((DEC_BATCH, DEC_SEQ, D)),
        "cache_sb_k": nrm((DEPTH, DEC_BATCH, PAST_LEN, H_SB, D_HEAD)),
        "cache_sb_v": nrm((DEPTH, DEC_BATCH, PAST_LEN, H_SB, D_HEAD)),
        "cache_sa_k": nrm((DEPTH, DEC_BATCH, PAST_LEN, H_SA, D_HEAD)),
        "cache_sa_v": nrm((DEPTH, DEC_BATCH, PAST_LEN, H_SA, D_HEAD)),
        "cache_idx_k": nrm((DEPTH, DEC_BATCH, PAST_LEN, D_IDX)),
        "state_ffn_conv": nrm((DEPTH, DEC_BATCH, CONV_W - 1, D_FF)),
        "c_prompt": nrm((BATCH, D)),
        "c_sample": nrm((DEC_BATCH, D)),
        "w_ada": nrm((DEPTH, D, 6 * D), 0.5 * D ** -0.5),
        "b_ada": nrm((DEPTH, 6 * D), 0.02),
        "g_mix": 1.0 + nrm((DEPTH, D), 0.02),
        "w_in": nrm((DEPTH, D, IN_COLS), D ** -0.5),
        "w_gate": nrm((DEPTH, D, 2 * D), D ** -0.5),
        "w_br_sb": nrm((DEPTH, W_SB, D), W_SB ** -0.5),
        "w_br_sa": nrm((DEPTH, W_SA, D), W_SA ** -0.5),
        "w_out": nrm((DEPTH, D, D), D ** -0.5),
        "rel_table": nrm((N_BUCKETS, H_SA), 0.5),
        "g_ffn": 1.0 + nrm((DEPTH, D), 0.02),
        "w_up": nrm((DEPTH, D, 2 * D_FF), D ** -0.5),
        "conv_w": nrm((DEPTH, CONV_W, D_FF), CONV_W ** -0.5),
        "conv_b": nrm((DEPTH, D_FF), 0.02),
        "w_down": nrm((DEPTH, D_FF, D), D_FF ** -0.5),
        "g_final": 1.0 + nrm((D,), 0.02),
    }


def reference(x_prompt, x_sample, cache_sb_k, cache_sb_v, cache_sa_k, cache_sa_v,
              cache_idx_k, state_ffn_conv, c_prompt, c_sample, w_ada, b_ada, g_mix,
              w_in, w_gate, w_br_sb, w_br_sa, w_out, rel_table, g_ffn, w_up, conv_w,
              conv_b, w_down, g_final):
    xp, xs = x_prompt, x_sample
    new_p, new_s = [], []
    for l in range(DEPTH):
        w = (w_ada[l], b_ada[l], g_mix[l], w_in[l], w_gate[l], w_br_sb[l], w_br_sa[l],
             w_out[l], rel_table, g_ffn[l], w_up[l], conv_w[l], conv_b[l], w_down[l])
        xp, sp = layer(xp, c_prompt, None, *w)
        past = (cache_sb_k[l], cache_sb_v[l], cache_sa_k[l], cache_sa_v[l],
                cache_idx_k[l], state_ffn_conv[l])
        xs, ss = layer(xs, c_sample, past, *w)
        new_p.append(sp)
        new_s.append(ss)
    y_prompt = rmsnorm(xp, g_final)
    y_sample = rmsnorm(xs, g_final)
    p_sb_k = jnp.stack([s[0] for s in new_p])
    p_sb_v = jnp.stack([s[1] for s in new_p])
    p_sa_k = jnp.stack([s[2] for s in new_p])
    p_sa_v = jnp.stack([s[3] for s in new_p])
    p_idx_k = jnp.stack([s[4] for s in new_p])
    p_conv = jnp.stack([s[5] for s in new_p])
    s_sb_k = jnp.stack([s[0] for s in new_s])
    s_sb_v = jnp.stack([s[1] for s in new_s])
    s_sa_k = jnp.stack([s[2] for s in new_s])
    s_sa_v = jnp.stack([s[3] for s in new_s])
    s_idx_k = jnp.stack([s[4] for s in new_s])
    s_conv = jnp.stack([s[5] for s in new_s])
    return (y_prompt, y_sample, p_sb_k, p_sb_v, p_sa_k, p_sa_v, p_idx_k, p_conv,
            s_sb_k, s_sb_v, s_sa_k, s_sa_v, s_idx_k, s_conv)
```

```cpp
#include <hip/hip_runtime.h>
#include <cstdio>
#include <cstdint>

constexpr int DM = 2048, SEQ = 16384, NSAMP = 32, DSEQ = 64, PAST = 2048, SKV = PAST + DSEQ;
constexpr int MP = 2 * SEQ, MS = NSAMP * DSEQ, MT = MP + MS;
constexpr int KVR = MP + NSAMP * SKV;
constexpr int NCAT = 11520, NGATE0 = 7424, DFF = 5632, NUP = 2 * DFF, WSB = 1024;
constexpr float EPS = 1e-6f;
constexpr size_t O_Y = 0, O_PSBK = 71303168, O_PSBV = 104857600, O_PSAK = 138412032, O_PSAV = 171966464, O_PIDX = 205520896, O_PCONV = 207618048,
                 O_SSBK = 207640576, O_SSBV = 209737728, O_SSAK = 211834880, O_SSAV = 213932032, O_SIDX = 216029184, O_SCONV = 216160256, O_END = 216520704;
constexpr size_t MiB = 1u << 20;
constexpr size_t WS_CTL = 0, CTL_ZERO_BYTES = 1 * MiB;
constexpr size_t WS_MOD = 1 * MiB;
constexpr size_t WS_WDOWN = 3 * MiB;
constexpr size_t WS_G = 25 * MiB;
constexpr size_t WS_XMID = WS_G;
constexpr size_t WS_KSB = 297 * MiB, WS_VSB = 493 * MiB, WS_KSA = 689 * MiB, WS_VSA = 885 * MiB;
constexpr size_t WS_TMP = 297 * MiB;
constexpr size_t WS_ACT = 297 * MiB;
constexpr size_t WS_TAIL = 700 * MiB;
constexpr size_t WS_HEAD = 708 * MiB;
constexpr size_t WS_HB = 1081 * MiB;
constexpr size_t WS_QSB = 1217 * MiB, WS_QSA = 1285 * MiB, WS_QIX = 1353 * MiB;
constexpr size_t WS_OSB = WS_HB, WS_OSA = WS_HB + 68 * MiB;
constexpr size_t WS_MRG = WS_QSB;
constexpr size_t WS_KIX = 1421 * MiB;
constexpr size_t WS_WIX = 1434 * MiB;
constexpr size_t WS_MASKP = 1437 * MiB;
constexpr size_t WS_MASKS = 1501 * MiB;
constexpr size_t WS_WCAT = 1502 * MiB;
constexpr size_t WS_WBRSB = 1547 * MiB, WS_WBRSA = 1551 * MiB, WS_WOUT = 1555 * MiB, WS_WUP = 1563 * MiB;
constexpr size_t WS_END = 1607 * MiB;
static_assert(WS_ACT + (size_t)MT * DFF * 2 <= WS_TAIL && WS_TAIL + (size_t)128 * 44 * 2 * 128 * 4 <= WS_HEAD && WS_HEAD + (size_t)128 * 44 * 4 * 128 * 4 <= WS_HB && WS_VSA + (size_t)KVR * 2048 <= WS_HB, "ws map");
constexpr int MASKP_PITCH = 512, MASKS_PITCH = 96;
constexpr int CW_BAR = 4096, CW_P10 = 8192, CW_P6 = 8256, CW_P6L = 9216, CW_P10L = 10240;
constexpr int RING_OFF = 0, RING_BYTES = 131072;
constexpr int LDS_BYTES = 163840;
constexpr int HALO_OFF = RING_BYTES;
constexpr int MISC_OFF = LDS_BYTES - 256;

#define GAS __attribute__((address_space(1)))
#define LAS __attribute__((address_space(3)))
typedef unsigned short bf16;
typedef unsigned v4u __attribute__((ext_vector_type(4)));
typedef unsigned v2u __attribute__((ext_vector_type(2)));
typedef float f32x4 __attribute__((ext_vector_type(4)));
typedef float f32x16 __attribute__((ext_vector_type(16)));
typedef short bf16x8 __attribute__((ext_vector_type(8)));
typedef short s16x4 __attribute__((ext_vector_type(4)));
#define LDS_WAIT() asm volatile("s_waitcnt lgkmcnt(0)" ::: "memory")
#define VM_WAIT() asm volatile("s_waitcnt vmcnt(0)" ::: "memory")
typedef float f32x2_ __attribute__((ext_vector_type(2)));
typedef __bf16 bf16x2_ __attribute__((ext_vector_type(2)));
__device__ __forceinline__ unsigned pk2(float lo, float hi) { const f32x2_ v = {lo, hi}; return __builtin_bit_cast(unsigned, __builtin_convertvector(v, bf16x2_)); }
__device__ __forceinline__ float bf2f(unsigned b16) { return __uint_as_float(b16 << 16); }
__device__ __forceinline__ float wave_sum(float v) {
#pragma unroll
    for (int o = 1; o < 64; o <<= 1) v += __shfl_xor(v, o);
    return v;
}
__device__ __forceinline__ float sigmoidf_(float x) { return __builtin_amdgcn_rcpf(1.f + __builtin_amdgcn_exp2f(-1.4426950408889634f * x)); }
__device__ __forceinline__ int mod_row(int row) { return row < MP ? (row >> 14) : 2 + ((row - MP) >> 6); }
__device__ __forceinline__ int kv_row(int row) { return row < MP ? row : MP + ((row - MP) >> 6) * SKV + PAST + ((row - MP) & 63); }
namespace pg8 {
#define PG8_LAS __attribute__((address_space(3)))
typedef unsigned short bf16_t;
typedef short bf16x8 __attribute__((ext_vector_type(8)));
typedef float f32x4 __attribute__((ext_vector_type(4)));
typedef unsigned u32x4 __attribute__((ext_vector_type(4)));
constexpr int BM = 256, BK = 64, HALF = 128, HTB = HALF * BK * 2  , STAGE_BYTES = 8 * HTB, NXCD = 8, WGM = 8;

__host__ __device__ __forceinline__ int lds_byte(int r, int c) { const int st = (r >> 4) * 2 + (c >> 5), rr = r & 15, cc = c & 31, ob = rr * 64 + cc * 2; return st * 1024 + (ob ^ (((ob >> 9) & 1) << 5)); }
__host__ __device__ __forceinline__ void stage_rc(int b, int& R, int& C) { const int st = b / 1024, sb = b % 1024, swz = sb ^ (((sb >> 9) & 1) << 5); R = (st >> 1) * 16 + swz / 64; C = (st & 1) * 32 + (swz % 64) / 2; }
__host__ __device__ __forceinline__ int perm32(int rho) { const int n = rho >> 4, i = rho & 15; return 8 * (i >> 2) + 4 * n + (i & 3); }

struct Unit { int pm, pn; };
struct Gemm { const bf16_t* A; const bf16_t* Bt; int M, N, K; };

struct StaticOrder {
    int nM, nN, nwg, G, c;
    __host__ __device__ void init(int M, int N, int G_, int c_) { nM = M / BM; nN = N / BM; nwg = nM * nN; G = G_; c = c_; }
    __host__ __device__ bool next(int i, Unit& u) const {
        const long L = (long)i * G + c; if (L >= nwg) return false;
        int wgid = (int)L; { const int q = nwg / NXCD, r = nwg % NXCD, xcd = wgid % NXCD, off = wgid / NXCD; wgid = (xcd < r ? xcd * (q + 1) : r * (q + 1) + (xcd - r) * q) + off; }
        const int nig = WGM * nN, gid = wgid / nig, fm = gid * WGM, gsz = (nM - fm) < WGM ? (nM - fm) : WGM;
        u.pm = fm + ((wgid % nig) % gsz); u.pn = (wgid % nig) / gsz; return true;
    }
    __device__ __forceinline__ void a_ready(const Unit&) const {}
    __device__ __forceinline__ void done(const Unit&) const {}
};
struct TailOrder {
    int pm0, nN, c;
    __host__ __device__ bool next(int i, Unit& u) const { if (i > 0 || c >= 8 * nN) return false; u.pm = pm0 + (c & 7); u.pn = c >> 3; return true; }
    __device__ __forceinline__ void a_ready(const Unit&) const {}
    __device__ __forceinline__ void done(const Unit&) const {}
};

__device__ __forceinline__ unsigned cvt_pk_bf16(float lo, float hi) { return ::pk2(lo, hi); }
__device__ __forceinline__ float sigm(float x) { return __builtin_amdgcn_rcpf(1.f + __builtin_amdgcn_exp2f(-1.4426950408889634f * x)); }
__device__ __forceinline__ u32x4 pack8bf(const f32x4 v0, const f32x4 v1) { u32x4 w; w.x = cvt_pk_bf16(v0[0], v0[1]); w.y = cvt_pk_bf16(v0[2], v0[3]); w.z = cvt_pk_bf16(v1[0], v1[1]); w.w = cvt_pk_bf16(v1[2], v1[3]); return w; }
__device__ __forceinline__ void unpack8bf(const u32x4 w, f32x4& a, f32x4& b) {
    a[0] = __uint_as_float(w.x << 16); a[1] = __uint_as_float(w.x & 0xffff0000u); a[2] = __uint_as_float(w.y << 16); a[3] = __uint_as_float(w.y & 0xffff0000u);
    b[0] = __uint_as_float(w.z << 16); b[1] = __uint_as_float(w.z & 0xffff0000u); b[2] = __uint_as_float(w.w << 16); b[3] = __uint_as_float(w.w & 0xffff0000u); }

struct EpiG1 {
    static constexpr bool PERM = true, AFTER_DRAIN = false;
    unsigned char* ws; float* out;
    __device__ __forceinline__ void operator()(const f32x4 (&acc)[2][2][4][2], const Unit& u, int wr, int wc, int fr, int fq) const {
        const int pn = u.pn, pm = u.pm; const bool samp = pm >= 128;
        const int colw = wc * 32 + 8 * fq, row0 = pm * BM + wr * 64 + fr;
        if (pn >= 29) {
            bf16_t* G = (bf16_t*)(ws + WS_G) + (pn - 29) * 256 + colw;
#pragma unroll
            for (int ai = 0; ai < 2; ++ai)
#pragma unroll
                for (int m = 0; m < 4; ++m) { bf16_t* rowp = G + (size_t)(row0 + ai * HALF + m * 16) * 4096;
#pragma unroll
                    for (int bj = 0; bj < 2; ++bj) { f32x4 v0 = acc[ai][bj][m][0], v1 = acc[ai][bj][m][1];
#pragma unroll
                        for (int j = 0; j < 4; ++j) { v0[j] = sigm(v0[j]); v1[j] = sigm(v1[j]); }
                        __builtin_nontemporal_store(pack8bf(v0, v1), (u32x4*)(rowp + bj * HALF)); } }
            return;
        }
        if (pn == 28) {
            if (colw >= 80) return;
#pragma unroll
            for (int ai = 0; ai < 2; ++ai)
#pragma unroll
                for (int m = 0; m < 4; ++m) { const int row = row0 + ai * HALF + m * 16; const f32x4 v0 = acc[ai][0][m][0], v1 = acc[ai][0][m][1];
                    if (colw < 64) {
                        const int kvr = samp ? MP + ((row - MP) >> 6) * SKV + PAST + ((row - MP) & 63) : row;
                        *(u32x4*)((bf16_t*)(ws + WS_KIX) + (size_t)kvr * 64 + colw) = pack8bf(v0, v1);
                        float* o = out + (samp ? O_SIDX + (size_t)(row - MP) * 64 : O_PIDX + (size_t)row * 64) + colw;
                        *(f32x4*)o = v0; *(f32x4*)(o + 4) = v1;
                    } else { float* o = (float*)(ws + WS_WIX) + (size_t)row * 16 + (colw - 64); *(f32x4*)o = v0; *(f32x4*)(o + 4) = v1; } }
            return;
        }
        const int seg = pn >> 2, cseg = (pn & 3) * 256 + colw;
        if (seg == 0 || seg == 3 || seg == 6) {
            bf16_t* Q = (bf16_t*)(ws + WS_QSB + (size_t)(seg / 3) * (68 * MiB)) + cseg;
#pragma unroll
            for (int ai = 0; ai < 2; ++ai)
#pragma unroll
                for (int m = 0; m < 4; ++m) { bf16_t* rowp = Q + (size_t)(row0 + ai * HALF + m * 16) * 1024;
#pragma unroll
                    for (int bj = 0; bj < 2; ++bj) { const u32x4 w8 = pack8bf(acc[ai][bj][m][0], acc[ai][bj][m][1]); if (seg == 3) __builtin_nontemporal_store(w8, (u32x4*)(rowp + bj * HALF)); else *(u32x4*)(rowp + bj * HALF) = w8; } }
            return;
        }
        const int j = seg < 3 ? seg - 1 : seg - 2;
        bf16_t* KV = (bf16_t*)(ws + WS_KSB + (size_t)j * (196 * MiB)) + cseg;
        float* OF = out + (samp ? O_SSBK + (size_t)j * 2097152 : O_PSBK + (size_t)j * 33554432) + cseg;
#pragma unroll
        for (int ai = 0; ai < 2; ++ai)
#pragma unroll
            for (int m = 0; m < 4; ++m) { const int row = row0 + ai * HALF + m * 16;
                const int kvr = samp ? MP + ((row - MP) >> 6) * SKV + PAST + ((row - MP) & 63) : row;
                bf16_t* rowb = KV + (size_t)kvr * 1024; float* rowf = OF + (size_t)(samp ? row - MP : row) * 1024;
#pragma unroll
                for (int bj = 0; bj < 2; ++bj) { const f32x4 v0 = acc[ai][bj][m][0], v1 = acc[ai][bj][m][1];
                    if (j >= 2) __builtin_nontemporal_store(pack8bf(v0, v1), (u32x4*)(rowb + bj * HALF)); else *(u32x4*)(rowb + bj * HALF) = pack8bf(v0, v1); __builtin_nontemporal_store(v0, (f32x4*)(rowf + bj * HALF)); __builtin_nontemporal_store(v1, (f32x4*)(rowf + bj * HALF + 4)); } }
    }
};
struct EpiBr1 {
    static constexpr bool PERM = true, AFTER_DRAIN = false;
    unsigned char* ws;
    __device__ __forceinline__ void operator()(const f32x4 (&acc)[2][2][4][2], const Unit& u, int wr, int wc, int fr, int fq) const {
        const int col0 = u.pn * BM + wc * 32 + 8 * fq, row0 = u.pm * BM + wr * 64 + fr;
#pragma unroll
        for (int ai = 0; ai < 2; ++ai)
#pragma unroll
            for (int m = 0; m < 4; ++m) { const size_t row = (size_t)(row0 + ai * HALF + m * 16);
                const bf16_t* g = (const bf16_t*)(ws + WS_G) + row * 4096 + col0; bf16_t* t = (bf16_t*)(ws + WS_TMP) + row * 2048 + col0;
#pragma unroll
                for (int bj = 0; bj < 2; ++bj) { f32x4 g0, g1; unpack8bf(*(const u32x4*)(g + bj * HALF), g0, g1);
                    *(u32x4*)(t + bj * HALF) = pack8bf(acc[ai][bj][m][0] * g0, acc[ai][bj][m][1] * g1); } }
    }
};
struct EpiBr2 {
    static constexpr bool PERM = true, AFTER_DRAIN = false;
    unsigned char* ws;
    __device__ __forceinline__ void operator()(const f32x4 (&acc)[2][2][4][2], const Unit& u, int wr, int wc, int fr, int fq) const {
        const int col0 = u.pn * BM + wc * 32 + 8 * fq, row0 = u.pm * BM + wr * 64 + fr;
#pragma unroll
        for (int ai = 0; ai < 2; ++ai)
#pragma unroll
            for (int m = 0; m < 4; ++m) { const size_t row = (size_t)(row0 + ai * HALF + m * 16);
                const bf16_t* g = (const bf16_t*)(ws + WS_G) + row * 4096 + 2048 + col0; const bf16_t* t = (const bf16_t*)(ws + WS_TMP) + row * 2048 + col0;
                bf16_t* o = (bf16_t*)(ws + WS_MRG) + row * 2048 + col0;
#pragma unroll
                for (int bj = 0; bj < 2; ++bj) { f32x4 g0, g1, t0, t1; unpack8bf(*(const u32x4*)(g + bj * HALF), g0, g1); unpack8bf(*(const u32x4*)(t + bj * HALF), t0, t1);
                    const f32x4 v0 = t0 + acc[ai][bj][m][0] * g0, v1 = t1 + acc[ai][bj][m][1] * g1;
                    *(u32x4*)(o + bj * HALF) = pack8bf(v0, v1); } }
    }
};
struct EpiRes {
    static constexpr bool PERM = true, AFTER_DRAIN = false;
    const float* base_p; const float* base_s; float* dst; const float* mod; int gchunk;
    __device__ __forceinline__ void operator()(const f32x4 (&acc)[2][2][4][2], const Unit& u, int wr, int wc, int fr, int fq) const {
        const int col0 = u.pn * BM + wc * 32 + 8 * fq, row0 = u.pm * BM + wr * 64 + fr;
#pragma unroll
        for (int ai = 0; ai < 2; ++ai) {
            const int rowa = row0 + ai * HALF;
            const float* gt = mod + (size_t)(rowa < MP ? (rowa >> 14) : 2 + ((rowa - MP) >> 6)) * 12288 + gchunk * 2048 + col0;
            const f32x4 g00 = *(const f32x4*)(gt), g01 = *(const f32x4*)(gt + 4), g10 = *(const f32x4*)(gt + HALF), g11 = *(const f32x4*)(gt + HALF + 4);
#pragma unroll
            for (int m = 0; m < 4; ++m) { const int row = rowa + m * 16;
                const float* b = (row < MP ? base_p + (size_t)row * 2048 : base_s + (size_t)(row - MP) * 2048) + col0;
                float* o = dst + (size_t)row * 2048 + col0;
                *(f32x4*)(o) = *(const f32x4*)(b) + g00 * acc[ai][0][m][0];
                *(f32x4*)(o + 4) = *(const f32x4*)(b + 4) + g01 * acc[ai][0][m][1];
                *(f32x4*)(o + HALF) = *(const f32x4*)(b + HALF) + g10 * acc[ai][1][m][0];
                *(f32x4*)(o + HALF + 4) = *(const f32x4*)(b + HALF + 4) + g11 * acc[ai][1][m][1]; } }
    }
};
#define PG8_DPP_ROR(x, n) __builtin_bit_cast(float, __builtin_amdgcn_update_dpp(0, __builtin_bit_cast(int, (x)), 0x120 + (n), 0xf, 0xf, false))
struct EpiUpConv {
    static constexpr bool PERM = true, AFTER_DRAIN = false;
    unsigned char* ws; float* out; const float* cw; const float* cb; const float* st; PG8_LAS float* halo;
    __device__ __forceinline__ void operator()(const f32x4 (&acc)[2][2][4][2], const Unit& u, int wr, int wc, int fr, int fq) const {
        const int pn = u.pn, pm = u.pm; const bool samp = pm >= 128;
        const int colw = wc * 32 + 8 * fq, ch0 = pn * 128 + colw, row0 = pm * BM + wr * 64 + fr;
        if (fr >= 14) {
#pragma unroll
            for (int ai = 0; ai < 2; ++ai) { PG8_LAS float* h = halo + ((ai * 2 + wr) * 2 + (fr - 14)) * 128 + colw;
                *(PG8_LAS f32x4*)h = acc[ai][0][3][0]; *(PG8_LAS f32x4*)(h + 4) = acc[ai][0][3][1]; } }
        asm volatile("s_waitcnt lgkmcnt(0)" ::: "memory"); __builtin_amdgcn_s_barrier(); asm volatile("" ::: "memory");
        float w0[8], w1[8], w2[8], bb[8];
#pragma unroll
        for (int j = 0; j < 8; ++j) { w0[j] = cw[ch0 + j]; w1[j] = cw[DFF + ch0 + j]; w2[j] = cw[2 * DFF + ch0 + j]; bb[j] = cb[ch0 + j]; }
#pragma unroll
        for (int ai = 0; ai < 2; ++ai) {
            float e1[8], e2[8];
            const int grow0 = pm * BM + ai * HALF + wr * 64;
            bool defer = false;
            if (samp) { const float* s0 = st + (size_t)((grow0 - MP) >> 6) * 2 * DFF + ch0;
#pragma unroll
                for (int j = 0; j < 8; ++j) { e2[j] = s0[j]; e1[j] = s0[DFF + j]; } }
            else if (ai == 0 && wr == 0) { defer = (pm & 63) != 0;
#pragma unroll
                for (int j = 0; j < 8; ++j) { e2[j] = 0.f; e1[j] = 0.f; } }
            else { const int pg = ai * 2 + wr - 1; const PG8_LAS float* h = halo + (pg * 2) * 128 + colw;
                const f32x4 a0 = *(const PG8_LAS f32x4*)h, a1 = *(const PG8_LAS f32x4*)(h + 4), b0 = *(const PG8_LAS f32x4*)(h + 128), b1 = *(const PG8_LAS f32x4*)(h + 132);
#pragma unroll
                for (int j = 0; j < 4; ++j) { e2[j] = a0[j]; e2[4 + j] = a1[j]; e1[j] = b0[j]; e1[4 + j] = b1[j]; } }
            float pr1[8], pr2[8];
#pragma unroll
            for (int j = 0; j < 8; ++j) { pr1[j] = e1[j]; pr2[j] = fr == 0 ? e2[j] : e1[j]; }
#pragma unroll
            for (int m = 0; m < 4; ++m) { const int row = row0 + ai * HALF + m * 16;
                float g[8], v[8], o[8];
#pragma unroll
                for (int j = 0; j < 4; ++j) { g[j] = acc[ai][0][m][0][j]; g[4 + j] = acc[ai][0][m][1][j]; v[j] = acc[ai][1][m][0][j]; v[4 + j] = acc[ai][1][m][1][j]; }
#pragma unroll
                for (int j = 0; j < 8; ++j) { const float r1 = PG8_DPP_ROR(g[j], 1), r2 = PG8_DPP_ROR(g[j], 2);
                    const float p1 = fr == 0 ? pr1[j] : r1;
                    const float p2 = fr <= 1 ? pr2[j] : r2;
                    const float cv = bb[j] + w0[j] * p2 + w1[j] * p1 + w2[j] * g[j];
                    o[j] = cv * sigm(cv) * v[j];
                    pr1[j] = r1; pr2[j] = r2; }
                if (!(defer && m == 0 && fr < 2)) { bf16_t* op = (bf16_t*)(ws + WS_ACT) + (size_t)row * DFF + ch0; __builtin_nontemporal_store(pack8bf((f32x4){o[0], o[1], o[2], o[3]}, (f32x4){o[4], o[5], o[6], o[7]}), (u32x4*)op); }
                if (m == 0 && fr < 2 && defer) { float* hp = (float*)(ws + WS_HEAD) + (((size_t)pm * 44 + pn) * 4 + fr) * 128 + colw;
#pragma unroll
                    for (int j = 0; j < 8; ++j) { hp[j] = g[j]; hp[256 + j] = v[j]; } }
                if (m == 3 && fr >= 14) {
                    if (!samp && ai == 1 && wr == 1) { float* tp = (float*)(ws + WS_TAIL) + (((size_t)pm * 44 + pn) * 2 + (fr - 14)) * 128 + colw;
#pragma unroll
                        for (int j = 0; j < 8; ++j) tp[j] = g[j]; }
                    float* so = nullptr;
                    if (!samp) { if (ai == 1 && wr == 1 && (pm & 63) == 63) so = out + O_PCONV + (size_t)((pm >> 6) * 2 + (fr - 14)) * DFF; }
                    else so = out + O_SCONV + (size_t)(((row - MP) >> 6) * 2 + (fr - 14)) * DFF;
                    if (so) {
#pragma unroll
                        for (int j = 0; j < 8; ++j) so[ch0 + j] = g[j]; } } }
        }
        asm volatile("s_waitcnt lgkmcnt(0)" ::: "memory"); __builtin_amdgcn_s_barrier(); asm volatile("" ::: "memory");
    }
};
template <class Epi, class Sched, bool ALIGN_EPI = false, bool SP2 = false>
__device__ __forceinline__ void gemm_phase(PG8_LAS unsigned char* lds, const Gemm g, const Sched& S, const Epi& E) {
    const int tid = threadIdx.x, wid = __builtin_amdgcn_readfirstlane(tid >> 6), lane = tid & 63, wr = wid >> 2, wc = wid & 3, fr = lane & 15, fq = lane >> 4;
    const int K = g.K, nt = K / BK;
    unsigned voffA[2], voffB[2];
#pragma unroll
    for (int i = 0; i < 2; ++i) { int R, C; stage_rc(tid * 16 + i * 8192, R, C); const int Rb = Epi::PERM ? ((R & ~31) + perm32(R & 31)) : R;
        voffA[i] = (unsigned)(R * K + C) * 2u; voffB[i] = (unsigned)(Rb * K + C) * 2u; }
    const size_t kstep = (size_t)(BK * 2);
    const size_t hstep = (size_t)HALF * K * 2;
    const size_t tstep = 2 * hstep;
    const unsigned ldsw = (unsigned)wid * 1024u;
    const int aoff = lds_byte(wr * 64 + fr, fq * 8), boff = lds_byte(wc * 32 + fr, fq * 8);
#define PG8_SA(b, h) (((b) * 2 + (h)) * HTB)
#define PG8_SB(b, h) ((4 + (b) * 2 + (h)) * HTB)
#define PG8_STAGE(bufoff, gbase, voff) do { _Pragma("unroll") for (int _i = 0; _i < 2; ++_i) \
        __builtin_amdgcn_global_load_lds((const unsigned*)((const char*)(gbase) + (voff)[_i]), (PG8_LAS unsigned*)(lds + (bufoff) + ldsw + _i * 8192), 16, 0, 0); } while (0)
#define PG8_LDA(dst, b, h) do { _Pragma("unroll") for (int m = 0; m < 4; ++m) _Pragma("unroll") for (int k = 0; k < 2; ++k) dst[m][k] = *(const PG8_LAS bf16x8*)(lds + PG8_SA(b, h) + aoff + m * 2048 + k * 1024); } while (0)
#define PG8_LDB(dst, b, h) do { _Pragma("unroll") for (int n = 0; n < 2; ++n) _Pragma("unroll") for (int k = 0; k < 2; ++k) dst[n][k] = *(const PG8_LAS bf16x8*)(lds + PG8_SB(b, h) + boff + n * 2048 + k * 1024); } while (0)
#define PG8_MMA(ai, bj, At, Bt) do { __builtin_amdgcn_s_setprio(1); _Pragma("unroll") for (int m = 0; m < 4; ++m) _Pragma("unroll") for (int n = 0; n < 2; ++n) _Pragma("unroll") for (int k = 0; k < 2; ++k) \
        acc[ai][bj][m][n] = __builtin_amdgcn_mfma_f32_16x16x32_bf16(Bt[n][k], At[m][k], acc[ai][bj][m][n], 0, 0, 0); __builtin_amdgcn_s_setprio(0); } while (0)
#define PG8_WAIT_V(n) asm volatile("s_waitcnt vmcnt(" #n ")" ::: "memory")
#define PG8_WAIT_L(n) asm volatile("s_waitcnt lgkmcnt(" #n ")" ::: "memory")
#define PG8_BAR __builtin_amdgcn_s_barrier()
#define PG8_SCHED __builtin_amdgcn_sched_barrier(0)
    Unit cur, nxt; int ui = 0;
    if (!S.next(0, cur)) return;
    f32x4 acc[2][2][4][2];
#pragma unroll
    for (int a = 0; a < 2; ++a)
#pragma unroll
        for (int b = 0; b < 2; ++b)
#pragma unroll
            for (int m = 0; m < 4; ++m)
#pragma unroll
                for (int n = 0; n < 2; ++n) acc[a][b][m][n] = (f32x4){0.f, 0.f, 0.f, 0.f};
    bf16x8 At[4][2], B0[2][2], B1[2][2];
    const char* cA = (const char*)g.A + (size_t)cur.pm * tstep; const char* cB = (const char*)g.Bt + (size_t)cur.pn * tstep;
    S.a_ready(cur);
    if constexpr (SP2) {
        PG8_STAGE(PG8_SB(0, 0), cB, voffB); PG8_STAGE(PG8_SB(0, 1), cB + hstep, voffB); PG8_STAGE(PG8_SA(0, 0), cA, voffA); PG8_STAGE(PG8_SA(0, 1), cA + hstep, voffA);
        if (wr == 1) PG8_BAR;
        PG8_WAIT_V(2); PG8_BAR;
        PG8_STAGE(PG8_SB(1, 0), cB + kstep, voffB); PG8_STAGE(PG8_SA(1, 0), cA + kstep, voffA); PG8_STAGE(PG8_SB(1, 1), cB + hstep + kstep, voffB);
        PG8_WAIT_V(6); PG8_BAR;
    } else {
        PG8_STAGE(PG8_SB(0, 0), cB, voffB); PG8_STAGE(PG8_SA(0, 0), cA, voffA); PG8_STAGE(PG8_SB(0, 1), cB + hstep, voffB); PG8_STAGE(PG8_SA(0, 1), cA + hstep, voffA);
        if (wr == 1) PG8_BAR;
        PG8_WAIT_V(4); PG8_BAR;
        PG8_STAGE(PG8_SB(1, 0), cB + kstep, voffB); PG8_STAGE(PG8_SA(1, 0), cA + kstep, voffA); PG8_STAGE(PG8_SB(1, 1), cB + hstep + kstep, voffB);
        PG8_WAIT_V(6); PG8_BAR;
    }
    for (;;) {
        const bool has_next = S.next(ui + 1, nxt);
        const char* nA = has_next ? (const char*)g.A + (size_t)nxt.pm * tstep : cA; const char* nB = has_next ? (const char*)g.Bt + (size_t)nxt.pn * tstep : cB;
        for (int t = 0; t < nt; t += 2) {
            const bool last = (t == nt - 2);
            const char* a1 = cA + (size_t)(t + 1) * kstep;
            const char* a2 = last ? nA : cA + (size_t)(t + 2) * kstep; const char* b2 = last ? nB : cB + (size_t)(t + 2) * kstep;
            const char* a3 = a2 + kstep; const char* b3 = b2 + kstep;
            if (last && has_next) S.a_ready(nxt);
            if constexpr (SP2) {
            PG8_LDB(B0, 0, 0); PG8_LDB(B1, 0, 1); PG8_SCHED; PG8_LDA(At, 0, 0); PG8_STAGE(PG8_SA(1, 1), a1 + hstep, voffA);
            PG8_WAIT_V(8); PG8_WAIT_L(0); PG8_BAR; PG8_MMA(0, 0, At, B0); PG8_MMA(0, 1, At, B1); PG8_BAR; PG8_SCHED;
            PG8_LDA(At, 0, 1); PG8_STAGE(PG8_SB(0, 0), b2, voffB); PG8_STAGE(PG8_SB(0, 1), b2 + hstep, voffB); PG8_STAGE(PG8_SA(0, 0), a2, voffA);
            PG8_WAIT_V(8); PG8_WAIT_L(0); PG8_BAR; PG8_MMA(1, 0, At, B0); PG8_MMA(1, 1, At, B1); PG8_BAR; PG8_SCHED;
            PG8_LDB(B0, 1, 0); PG8_LDB(B1, 1, 1); PG8_SCHED; PG8_LDA(At, 1, 0); PG8_STAGE(PG8_SA(0, 1), a2 + hstep, voffA);
            PG8_WAIT_V(8); PG8_WAIT_L(0); PG8_BAR; PG8_MMA(0, 0, At, B0); PG8_MMA(0, 1, At, B1); PG8_BAR; PG8_SCHED;
            PG8_LDA(At, 1, 1); PG8_STAGE(PG8_SB(1, 0), b3, voffB); PG8_STAGE(PG8_SB(1, 1), b3 + hstep, voffB); PG8_STAGE(PG8_SA(1, 0), a3, voffA);
            PG8_WAIT_V(8); PG8_WAIT_L(0); PG8_BAR; PG8_MMA(1, 0, At, B0); PG8_MMA(1, 1, At, B1); PG8_BAR; PG8_SCHED;
            } else {
            PG8_LDB(B0, 0, 0); PG8_SCHED; PG8_LDA(At, 0, 0); PG8_STAGE(PG8_SA(1, 1), a1 + hstep, voffA);
            PG8_WAIT_L(8); PG8_BAR; PG8_WAIT_L(0); PG8_MMA(0, 0, At, B0); PG8_BAR; PG8_SCHED;
            PG8_LDB(B1, 0, 1); PG8_STAGE(PG8_SB(0, 0), b2, voffB);
            PG8_BAR; PG8_WAIT_L(0); PG8_MMA(0, 1, At, B1); PG8_BAR;
            PG8_LDA(At, 0, 1); PG8_STAGE(PG8_SA(0, 0), a2, voffA);
            PG8_BAR; PG8_WAIT_L(0); PG8_MMA(1, 0, At, B0); PG8_BAR; PG8_SCHED;
            PG8_STAGE(PG8_SB(0, 1), b2 + hstep, voffB);
            PG8_WAIT_V(6); PG8_BAR; PG8_MMA(1, 1, At, B1); PG8_BAR;
            PG8_LDB(B0, 1, 0); PG8_SCHED; PG8_LDA(At, 1, 0); PG8_STAGE(PG8_SA(0, 1), a2 + hstep, voffA);
            PG8_WAIT_L(8); PG8_BAR; PG8_WAIT_L(0); PG8_MMA(0, 0, At, B0); PG8_BAR; PG8_SCHED;
            PG8_LDB(B1, 1, 1); PG8_STAGE(PG8_SB(1, 0), b3, voffB);
            PG8_BAR; PG8_WAIT_L(0); PG8_MMA(0, 1, At, B1); PG8_BAR;
            PG8_LDA(At, 1, 1); PG8_STAGE(PG8_SA(1, 0), a3, voffA);
            PG8_BAR; PG8_WAIT_L(0); PG8_MMA(1, 0, At, B0); PG8_BAR; PG8_SCHED;
            PG8_STAGE(PG8_SB(1, 1), b3 + hstep, voffB);
            PG8_WAIT_V(6); PG8_BAR; PG8_MMA(1, 1, At, B1); PG8_BAR;
            }
        }
        if constexpr (ALIGN_EPI) { if (wr == 0) PG8_BAR; }
        if constexpr (!Epi::AFTER_DRAIN) { E(acc, cur, wr, wc, fr, fq); S.done(cur); }
        if (!has_next) break;
#pragma unroll
        for (int a = 0; a < 2; ++a)
#pragma unroll
            for (int b = 0; b < 2; ++b)
#pragma unroll
                for (int m = 0; m < 4; ++m)
#pragma unroll
                    for (int n = 0; n < 2; ++n) acc[a][b][m][n] = (f32x4){0.f, 0.f, 0.f, 0.f};
        cur = nxt; cA = nA; cB = nB; ++ui;
        if constexpr (ALIGN_EPI) { if (wr == 1) PG8_BAR; }
    }
    PG8_WAIT_V(0);
    if constexpr (!ALIGN_EPI) { if (wr == 0) PG8_BAR; }
    PG8_BAR;
    if constexpr (Epi::AFTER_DRAIN) { E.fused(acc, cur, wr, wc, fr, fq, lds, wid, lane); S.done(cur); }
#undef PG8_SA
#undef PG8_SB
#undef PG8_STAGE
#undef PG8_LDA
#undef PG8_LDB
#undef PG8_MMA
#undef PG8_WAIT_V
#undef PG8_WAIT_L
#undef PG8_BAR
#undef PG8_SCHED
}
}
#define XB_TMO      128
#define XB_XCNT(j)  (256  + 64 * (j))
#define XB_XSUB(j)  (1280 + 64 * (j))
#define XB_XGEN(j)  (2304 + 64 * (j))
#define XB_TOP      3328
#define XB_TOPGEN   3392
#define XCD_BAR_WORDS 3456
#define XB_SPIN_CAP (1u << 18)
#define LAS __attribute__((address_space(3)))

__device__ __forceinline__ unsigned xb_ld(unsigned* p)              { return __hip_atomic_load(p, __ATOMIC_RELAXED, __HIP_MEMORY_SCOPE_AGENT); }
__device__ __forceinline__ unsigned xb_add(unsigned* p, unsigned v) { return __hip_atomic_fetch_add(p, v, __ATOMIC_RELAXED, __HIP_MEMORY_SCOPE_AGENT); }
__device__ __forceinline__ unsigned xb_xcc_id() { return (unsigned)__builtin_amdgcn_s_getreg((3 << 11) | 20) & 0xFu; }
#define XB_SPIN(cond, bar) do { unsigned _sp = 0; while (cond) { __builtin_amdgcn_s_sleep(1); \
    if ((++_sp & 255u) == 0u) { if (xb_ld(&(bar)[XB_TMO])) break; if (_sp > XB_SPIN_CAP) { atomicAdd(&(bar)[XB_TMO], 1u); break; } } } } while (0)

struct XcdBarrier {
    unsigned* bar; unsigned x;
    volatile LAS unsigned* st;
};

__device__ __forceinline__ XcdBarrier xcd_barrier_post(unsigned* bar, volatile LAS unsigned* st) {
    XcdBarrier b; b.bar = bar; b.x = xb_xcc_id(); b.st = st;
    if (threadIdx.x == 0) (void)xb_add(&bar[XB_XCNT(b.x)], 1u);
    return b;
}
__device__ __forceinline__ void xcd_barrier_complete(unsigned* bar, unsigned x, unsigned& nloc, unsigned& nx) {
    const unsigned G = gridDim.x * gridDim.y * gridDim.z;
    unsigned sum, cnt, mine, sp = 0u;
    for (;;) {
        sum = 0u; cnt = 0u; mine = 0u;
#pragma unroll
        for (unsigned j = 0; j < 16; ++j) { const unsigned c = xb_ld(&bar[XB_XCNT(j)]); sum += c; cnt += (c > 0u) ? 1u : 0u; mine = (j == x) ? c : mine; }
        if (sum == G) break;
        __builtin_amdgcn_s_sleep(1);
        if ((++sp & 255u) == 0u) { if (xb_ld(&bar[XB_TMO])) break; if (sp > XB_SPIN_CAP) { atomicAdd(&bar[XB_TMO], 1u); break; } }
    }
    nloc = mine > 0u ? mine : 1u; nx = cnt > 0u ? cnt : 1u;
}

__device__ __forceinline__ void xcd_barrier(const XcdBarrier& b) {
    asm volatile("s_waitcnt vmcnt(0)" ::: "memory");
    __syncthreads();
    if (threadIdx.x == 0) {
        unsigned* bar = b.bar;
        __builtin_amdgcn_s_waitcnt(0);
        unsigned nloc = b.st[0], nx = b.st[1];
        if (nloc == 0u) { xcd_barrier_complete(bar, b.x, nloc, nx); b.st[0] = nloc; b.st[1] = nx; }
        const unsigned old = xb_add(&bar[XB_XSUB(b.x)], 1u);
        const unsigned gen = old / nloc;
        if (old + 1u == (gen + 1u) * nloc) {
            __builtin_amdgcn_fence(__ATOMIC_RELEASE, "agent");
            asm volatile("s_waitcnt vmcnt(0)" ::: "memory");
            const unsigned og = xb_add(&bar[XB_TOP], 1u);
            const unsigned tg = og / nx;
            if (og + 1u == (tg + 1u) * nx) xb_add(&bar[XB_TOPGEN], 1u);
            else XB_SPIN(xb_ld(&bar[XB_TOPGEN]) == tg, bar);
            __builtin_amdgcn_fence(__ATOMIC_ACQUIRE, "agent");
            xb_add(&bar[XB_XGEN(b.x)], 1u);
            asm volatile("s_waitcnt vmcnt(0)" ::: "memory");
        } else {
            XB_SPIN(xb_ld(&bar[XB_XGEN(b.x)]) == gen, bar);
            __builtin_amdgcn_fence(__ATOMIC_ACQUIRE, "agent");
            asm volatile("s_waitcnt vmcnt(0)" ::: "memory");
        }
    }
    __syncthreads();
}
__device__ __forceinline__ void xcd_count_in(const XcdBarrier& b, unsigned* loc, unsigned* glob) {
    const unsigned nloc = b.st[0];
    const unsigned old = xb_add(loc + 64 * b.x, 1u);
    if (old + 1u == nloc) { __builtin_amdgcn_fence(__ATOMIC_RELEASE, "agent"); asm volatile("s_waitcnt vmcnt(0)" ::: "memory"); (void)xb_add(glob, nloc); }
}
constexpr int NWAVES = 8;
struct Frame {
    LAS unsigned char* lds;
    unsigned char* ws; float* out;
    int tid, lane, wave, G, c;
    const float* in[25];
};
enum { I_XP = 0, I_XS, I_CSBK, I_CSBV, I_CSAK, I_CSAV, I_CIDX, I_CONVST, I_CP, I_CS, I_WADA, I_BADA, I_GMIX, I_WIN, I_WGATE, I_WBRSB, I_WBRSA, I_WOUT, I_REL, I_GFFN, I_WUP, I_CONVW, I_CONVB, I_WDOWN, I_GFINAL };

__device__ __forceinline__ void p0_transpose_item(const float* W, int K, int N, bf16* WT, int row_off, LAS float* scr, int item, int lane) {
    const int nblk = (N + 31) / 32, kb = item / nblk, nb = item % nblk, k0 = 64 * kb, n0 = 32 * nb;
    const int cg = 4 * (lane & 7); const bool cok = (n0 + cg) < N;
    f32x4 tv[8];
#pragma unroll
    for (int i = 0; i < 8; ++i) { const int kk = 8 * i + (lane >> 3); tv[i] = cok ? *(const GAS f32x4*)(W + (size_t)(k0 + kk) * N + n0 + cg) : (f32x4){0.f, 0.f, 0.f, 0.f}; }
#pragma unroll
    for (int i = 0; i < 8; ++i) { LAS float* d = scr + (8 * i + (lane >> 3)) * 33 + cg; d[0] = tv[i][0]; d[1] = tv[i][1]; d[2] = tv[i][2]; d[3] = tv[i][3]; }
    LDS_WAIT(); asm volatile("" ::: "memory");
    const int c = lane & 7;
#pragma unroll
    for (int j = 0; j < 4; ++j) { const int n = (lane >> 3) + 8 * j; const LAS float* s = scr + (8 * c) * 33 + n;
        v4u o; o.x = pk2(s[0 * 33], s[1 * 33]); o.y = pk2(s[2 * 33], s[3 * 33]); o.z = pk2(s[4 * 33], s[5 * 33]); o.w = pk2(s[6 * 33], s[7 * 33]);
        if (n0 + n < N) *(GAS v4u*)(WT + (size_t)(row_off + n0 + n) * K + k0 + 8 * c) = o; }
    LDS_WAIT(); asm volatile("" ::: "memory");
}
__device__ __forceinline__ void p0_mod(Frame& F, int blk) {
    const float* wada = F.in[I_WADA]; const int l15 = F.lane & 15, l4 = F.lane >> 4;
    f32x4 acc[3][4];
#pragma unroll
    for (int rb = 0; rb < 3; ++rb)
#pragma unroll
        for (int cb = 0; cb < 4; ++cb) acc[rb][cb] = (f32x4){0.f, 0.f, 0.f, 0.f};
    const int kw = F.wave * 256 + l4;
    const float* a0 = F.in[I_CP] + (size_t)(l15 < 2 ? l15 : 0) * DM + kw;
    const float* a0s = F.in[I_CS] + (size_t)(l15 < 2 ? 0 : l15 - 2) * DM + kw;
    const float* a1 = F.in[I_CS] + (size_t)(14 + l15) * DM + kw;
    const float* a2 = F.in[I_CS] + (size_t)(l15 < 2 ? 30 + l15 : 30) * DM + kw;
    const float* bp = wada + (size_t)kw * 12288 + blk * 64 + l15;
#pragma unroll 4
    for (int ks = 0; ks < 64; ++ks) {
        const float c0 = l15 < 2 ? a0[4 * ks] : a0s[4 * ks], c1 = a1[4 * ks], c2 = l15 < 2 ? a2[4 * ks] : 0.f;
        const float s0 = c0 * sigmoidf_(c0), s1 = c1 * sigmoidf_(c1), s2 = c2 * sigmoidf_(c2);
        float bv[4];
#pragma unroll
        for (int cb = 0; cb < 4; ++cb) bv[cb] = bp[(size_t)(4 * ks) * 12288 + 16 * cb];
#pragma unroll
        for (int cb = 0; cb < 4; ++cb) { acc[0][cb] = __builtin_amdgcn_mfma_f32_16x16x4f32(s0, bv[cb], acc[0][cb], 0, 0, 0);
                                         acc[1][cb] = __builtin_amdgcn_mfma_f32_16x16x4f32(s1, bv[cb], acc[1][cb], 0, 0, 0);
                                         acc[2][cb] = __builtin_amdgcn_mfma_f32_16x16x4f32(s2, bv[cb], acc[2][cb], 0, 0, 0); }
    }
    LAS float* red = (LAS float*)(F.lds + RING_OFF);
#pragma unroll
    for (int rb = 0; rb < 3; ++rb)
#pragma unroll
        for (int cb = 0; cb < 4; ++cb)
#pragma unroll
            for (int i = 0; i < 4; ++i) { const int row = 16 * rb + 4 * l4 + i; if (row < 34) red[(F.wave * 34 + row) * 64 + 16 * cb + l15] = acc[rb][cb][i]; }
    __syncthreads();
    float* mod = (float*)(F.ws + WS_MOD);
    for (int o = F.tid; o < 34 * 64; o += NWAVES * 64) { const int b = o >> 6, l = o & 63; float v = F.in[I_BADA][blk * 64 + l];
#pragma unroll
        for (int w = 0; w < 8; ++w) v += red[(w * 34 + b) * 64 + l];
        mod[(size_t)b * 12288 + blk * 64 + l] = v; }
    __syncthreads();
}
__device__ __forceinline__ void p0_prologue(Frame& F) {
    if (F.c < 192) p0_mod(F, F.c);
    LAS float* scr = (LAS float*)(F.lds + RING_OFF + F.wave * 16384);
    const int gw = F.c * NWAVES + F.wave, NGW = F.G * NWAVES;
    constexpr int I0 = 32 * 227, I1 = 32 * 128, I2 = 16 * 64, I3 = 16 * 64, I4 = 32 * 64, I5 = 32 * 352, I6 = 88 * 64;
    constexpr int NITEMS = I0 + I1 + I2 + I3 + I4 + I5 + I6;
    for (int it = gw; it < NITEMS; it += NGW) {
        int r = it;
        if (r < I0) { p0_transpose_item(F.in[I_WIN], 2048, 7248, (bf16*)(F.ws + WS_WCAT), 0, scr, r, F.lane); continue; } r -= I0;
        if (r < I1) { p0_transpose_item(F.in[I_WGATE], 2048, 4096, (bf16*)(F.ws + WS_WCAT), NGATE0, scr, r, F.lane); continue; } r -= I1;
        if (r < I2) { p0_transpose_item(F.in[I_WBRSB], 1024, 2048, (bf16*)(F.ws + WS_WBRSB), 0, scr, r, F.lane); continue; } r -= I2;
        if (r < I3) { p0_transpose_item(F.in[I_WBRSA], 1024, 2048, (bf16*)(F.ws + WS_WBRSA), 0, scr, r, F.lane); continue; } r -= I3;
        if (r < I4) { p0_transpose_item(F.in[I_WOUT], 2048, 2048, (bf16*)(F.ws + WS_WOUT), 0, scr, r, F.lane); continue; } r -= I4;
        if (r < I5) { const int n0 = 32 * (r % 352), bj = n0 / DFF, ch = n0 % DFF;
            p0_transpose_item(F.in[I_WUP], 2048, NUP, (bf16*)(F.ws + WS_WUP), 256 * (ch >> 7) + 128 * bj + (ch & 127) - n0, scr, r, F.lane); continue; } r -= I5;
        p0_transpose_item(F.in[I_WDOWN], DFF, 2048, (bf16*)(F.ws + WS_WDOWN), 0, scr, r, F.lane);
    }
    const size_t gt = (size_t)F.c * (NWAVES * 64) + F.tid, NGT = (size_t)F.G * NWAVES * 64;
    for (size_t i = gt; i < 45056; i += NGT) *(GAS v4u*)((bf16*)(F.ws + WS_WCAT) + (size_t)7248 * 2048 + i * 8) = (v4u){0u, 0u, 0u, 0u};
    { const float* src = F.in[I_CIDX]; bf16* dst = (bf16*)(F.ws + WS_KIX);
        for (size_t i = gt; i < (size_t)524288; i += NGT) { const size_t e = i * 8, s = e >> 17, rem = e & 131071;
            const f32x4 a = *(const GAS f32x4*)(src + e), b = *(const GAS f32x4*)(src + e + 4);
            v4u o; o.x = pk2(a[0], a[1]); o.y = pk2(a[2], a[3]); o.z = pk2(b[0], b[1]); o.w = pk2(b[2], b[3]);
            *(GAS v4u*)(dst + ((size_t)MP + s * SKV) * 64 + rem) = o; } }
}
__device__ __forceinline__ void norm_mod_rows(Frame& F, const float* xp, const float* xs, const float* g, int shchunk, int scchunk, int row0, int row1, int widx, int nw) {
    const int gw = widx * NWAVES + F.wave, NGW = nw * NWAVES; const float* mod = (const float*)(F.ws + WS_MOD);
    f32x4 gj[8], scj[8], shj[8]; int cur = -1;
#pragma unroll
    for (int j = 0; j < 8; ++j) gj[j] = *(const f32x4*)(g + 4 * (F.lane + 64 * j));
    f32x4 v[8], vn[8];
    { const int row = row0 + gw; if (row < row1) { const GAS f32x4* xr = (const GAS f32x4*)(row < MP ? xp + (size_t)row * DM : xs + (size_t)(row - MP) * DM) + F.lane;
#pragma unroll
        for (int j = 0; j < 8; ++j) v[j] = xr[64 * j]; } }
    for (int row = row0 + gw; row < row1; row += NGW) {
        { const int rn = row + NGW < row1 ? row + NGW : row; const GAS f32x4* xr = (const GAS f32x4*)(rn < MP ? xp + (size_t)rn * DM : xs + (size_t)(rn - MP) * DM) + F.lane;
#pragma unroll
          for (int j = 0; j < 8; ++j) vn[j] = xr[64 * j]; }
        float ss = 0.f;
#pragma unroll
        for (int j = 0; j < 8; ++j) ss += (v[j].x * v[j].x + v[j].y * v[j].y) + (v[j].z * v[j].z + v[j].w * v[j].w);
        const int mrow = mod_row(row);
        if (mrow != cur) { cur = mrow; const float* mr = mod + (size_t)mrow * 12288;
#pragma unroll
            for (int j = 0; j < 8; ++j) { const int col = 4 * (F.lane + 64 * j); shj[j] = *(const f32x4*)(mr + shchunk * 2048 + col); scj[j] = *(const f32x4*)(mr + scchunk * 2048 + col) + 1.f; } }
        const float rstd = 1.f / sqrtf(wave_sum(ss) * (1.f / DM) + EPS);
        GAS v2u* o8 = (GAS v2u*)((bf16*)(F.ws + WS_HB) + (size_t)row * DM) + F.lane;
#pragma unroll
        for (int j = 0; j < 8; ++j) {
            const f32x4 y = (v[j] * rstd) * gj[j] * scj[j] + shj[j];
            v2u w; w.x = pk2(y[0], y[1]); w.y = pk2(y[2], y[3]); o8[64 * j] = w; }
#pragma unroll
        for (int j = 0; j < 8; ++j) v[j] = vn[j];
    }
}
__device__ __forceinline__ void final_norm_rows(Frame& F, int row0, int row1, int widx, int nw) {
    const int gw = widx * NWAVES + F.wave, NGW = nw * NWAVES; const float* g = F.in[I_GFINAL];
    f32x4 gj[8];
#pragma unroll
    for (int j = 0; j < 8; ++j) gj[j] = *(const f32x4*)(g + 4 * (F.lane + 64 * j));
    for (int row = row0 + gw; row < row1; row += NGW) {
        GAS f32x4* xr = (GAS f32x4*)(F.out + O_Y + (size_t)row * DM) + F.lane;
        f32x4 v[8]; float ss = 0.f;
#pragma unroll
        for (int j = 0; j < 8; ++j) { v[j] = xr[64 * j]; ss += (v[j].x * v[j].x + v[j].y * v[j].y) + (v[j].z * v[j].z + v[j].w * v[j].w); }
        const float rstd = 1.f / sqrtf(wave_sum(ss) * (1.f / DM) + EPS);
#pragma unroll
        for (int j = 0; j < 8; ++j) xr[64 * j] = (v[j] * rstd) * gj[j];
    }
}
__device__ __forceinline__ void conv_fix(Frame& F) {
    const size_t gt = (size_t)F.c * (NWAVES * 64) + F.tid, NGT = (size_t)F.G * NWAVES * 64;
    const float* cw = F.in[I_CONVW]; const float* cb = F.in[I_CONVB];
    const float* TAIL = (const float*)(F.ws + WS_TAIL); const float* HEAD = (const float*)(F.ws + WS_HEAD); bf16* A = (bf16*)(F.ws + WS_ACT);
    for (size_t it = gt; it < (size_t)128 * 44 * 128; it += NGT) {
        const int c = (int)(it & 127), pn = (int)((it >> 7) % 44), pm = (int)((it >> 7) / 44);
        if ((pm & 63) == 0) continue;
        const int ch = pn * 128 + c;
        const float* t = TAIL + ((size_t)(pm - 1) * 44 + pn) * 2 * 128 + c; const float* h = HEAD + ((size_t)pm * 44 + pn) * 4 * 128 + c;
        const float t0 = t[0], t1 = t[128], g0 = h[0], g1 = h[128], v0 = h[256], v1 = h[384];
        const float w0 = cw[ch], w1 = cw[DFF + ch], w2 = cw[2 * DFF + ch], b = cb[ch];
        const float c0 = b + w0 * t0 + w1 * t1 + w2 * g0, c1 = b + w0 * t1 + w1 * g0 + w2 * g1;
        A[(size_t)(pm * 256) * DFF + ch] = (bf16)(pk2(c0 * sigmoidf_(c0) * v0, 0.f) & 0xffffu);
        A[(size_t)(pm * 256 + 1) * DFF + ch] = (bf16)(pk2(c1 * sigmoidf_(c1) * v1, 0.f) & 0xffffu);
    }
}
constexpr int AT_K0 = 0, AT_V0 = 32768, AT_FLAGS = 65536, AT_TAB = 65536 + 256;
constexpr int DS_K0 = 0, DS_V0 = 65536, DS_MASK = 131072, DS_TAB = 131072 + 8192, DS_TABN = DS_TAB + 256, DS_TABN_OFF = 653, DS_TABN_N = 720;
#define MFMA32(a, b, c) __builtin_amdgcn_mfma_f32_32x32x16_bf16((a), (b), (c), 0, 0, 0)
struct AttnUnit { int kv_base, q_tok0, q_pos0, nqw, head; const float* ck; const float* cv; };

__device__ __forceinline__ void at_stage(LAS unsigned char* dst, const bf16* src  , int wave, int lane) {
#pragma unroll
    for (int i = 0; i < 2; ++i) { const int piece = i * 8 + wave, row = 4 * piece + (lane >> 4), ch = (lane & 15) ^ (((row & 3) << 2) | ((row >> 2) & 3));
        __builtin_amdgcn_global_load_lds((const unsigned*)((const char*)src + (size_t)row * 2048 + ch * 16), (LAS unsigned*)(dst + piece * 1024), 16, 0, 0); }
}
__device__ __forceinline__ void at_stage_f32(LAS unsigned char* dst, const float* src  , int wave, int lane) {
#pragma unroll
    for (int i = 0; i < 2; ++i) { const int piece = i * 8 + wave, row = 4 * piece + (lane >> 4), ch = (lane & 15) ^ (((row & 3) << 2) | ((row >> 2) & 3));
        const float* g = src + (size_t)row * 1024 + ch * 8; const f32x4 a = *(const GAS f32x4*)g, b = *(const GAS f32x4*)(g + 4);
        v4u o; o.x = pk2(a[0], a[1]); o.y = pk2(a[2], a[3]); o.z = pk2(b[0], b[1]); o.w = pk2(b[2], b[3]);
        *(LAS v4u*)(dst + piece * 1024 + lane * 16) = o; }
}
__device__ __forceinline__ void at_koffs(int lane, int (&ko)[8]) { const int row = lane & 31, hi = lane >> 5, sw = ((row & 3) << 2) | ((row >> 2) & 3);
#pragma unroll
    for (int ks = 0; ks < 8; ++ks) ko[ks] = 256 * row + 16 * ((2 * ks + hi) ^ sw); }
__device__ __forceinline__ void at_voffs(int lane, int (&vo)[4][2]) { const int hi = lane >> 5, q = (lane >> 2) & 3, cl = 2 * ((lane >> 4) & 1) + ((lane & 3) >> 1);
#pragma unroll
    for (int mt = 0; mt < 4; ++mt)
#pragma unroll
        for (int e = 0; e < 2; ++e) { const int row = 4 * hi + q + 8 * e, sw = ((row & 3) << 2) | ((row >> 2) & 3); vo[mt][e] = 256 * row + 16 * ((4 * mt + cl) ^ sw) + 8 * (lane & 1); } }
__device__ __forceinline__ f32x16 at_qk(const LAS unsigned char* kt, const int (&ko)[8], int sub, const bf16x8 (&qf)[8]) {
    f32x16 p;
#pragma unroll
    for (int r = 0; r < 16; ++r) p[r] = 0.f;
#pragma unroll
    for (int ks = 0; ks < 8; ++ks) { const bf16x8 a = *(const LAS bf16x8*)(kt + ko[ks] + sub * 8192); p = MFMA32(a, qf[ks], p); }
    return p;
}
__device__ __forceinline__ void at_pv_w(f32x16 (&o)[4], const LAS unsigned char* vt, const int (&vo)[4][2], int sub, const unsigned (&pw)[8]) {
#pragma unroll
    for (int s = 0; s < 2; ++s) {
        const v4u w = {pw[4 * s], pw[4 * s + 1], pw[4 * s + 2], pw[4 * s + 3]};
        const bf16x8 pb = __builtin_bit_cast(bf16x8, w);
        s16x4 lo[4], hi4[4];
#pragma unroll
        for (int mt = 0; mt < 4; ++mt) { lo[mt] = __builtin_amdgcn_ds_read_tr16_b64_v4i16((LAS s16x4*)(vt + vo[mt][0] + 256 * (16 * s + 32 * sub)));
                                         hi4[mt] = __builtin_amdgcn_ds_read_tr16_b64_v4i16((LAS s16x4*)(vt + vo[mt][1] + 256 * (16 * s + 32 * sub))); }
#pragma unroll
        for (int mt = 0; mt < 4; ++mt) { const bf16x8 va = (bf16x8){lo[mt][0], lo[mt][1], lo[mt][2], lo[mt][3], hi4[mt][0], hi4[mt][1], hi4[mt][2], hi4[mt][3]};
            o[mt] = MFMA32(va, pb, o[mt]); } }
}
__device__ __forceinline__ void at_pv(f32x16 (&o)[4], const LAS unsigned char* vt, const int (&vo)[4][2], int sub, const f32x16& pr) {
    unsigned pw[8];
#pragma unroll
    for (int k = 0; k < 8; ++k) pw[k] = pk2(pr[2 * k], pr[2 * k + 1]);
    at_pv_w(o, vt, vo, sub, pw);
}
__device__ __forceinline__ void at_load_q(bf16x8 (&qf)[8], const bf16* Q, int tok, int head, int lane) {
    int off = tok * 1024 + head * 128 + 8 * (lane >> 5);
    asm volatile("" : "+v"(off));
    const bf16* p = Q + off;
#pragma unroll
    for (int ks = 0; ks < 8; ++ks) qf[ks] = *(const GAS bf16x8*)(p + 16 * ks);
}
__device__ __forceinline__ void at_store_o(const f32x16 (&o)[4], float inv, bf16* O, int tok, int head, int lane) {
    asm volatile("" : "+v"(tok));
    bf16* p = O + (size_t)tok * 1024 + head * 128 + 4 * (lane >> 5);
#pragma unroll
    for (int mt = 0; mt < 4; ++mt)
#pragma unroll
        for (int g = 0; g < 4; ++g) { v2u w; w.x = pk2(o[mt][4 * g] * inv, o[mt][4 * g + 1] * inv); w.y = pk2(o[mt][4 * g + 2] * inv, o[mt][4 * g + 3] * inv);
            *(GAS v2u*)(p + 32 * mt + 8 * g) = w; }
}
__device__ __forceinline__ float xhalf(float v) { return __shfl_xor(v, 32); }

__device__ __forceinline__ void sb_unit(Frame& F, const AttnUnit& U) {
    const bf16* Kb = (const bf16*)(F.ws + WS_KSB) + (size_t)U.kv_base * 1024 + U.head * 128;
    const bf16* Vb = (const bf16*)(F.ws + WS_VSB) + (size_t)U.kv_base * 1024 + U.head * 128;
    bf16* QO = (bf16*)(F.ws + WS_QSB);
    const int lane = F.lane, wave = F.wave, ql = lane & 31, hi = lane >> 5;
    const bool haveq = wave < U.nqw;
    const int tok = U.q_tok0 + 32 * (haveq ? wave : 0) + ql, qpos = U.q_pos0 + 32 * (haveq ? wave : 0) + ql;
    int ko[8], vo[4][2]; at_koffs(lane, ko); at_voffs(lane, vo);
    bf16x8 qf[8]; at_load_q(qf, QO, tok, U.head, lane);
    f32x16 o[4];
#pragma unroll
    for (int mt = 0; mt < 4; ++mt)
#pragma unroll
        for (int r = 0; r < 16; ++r) o[mt][r] = 0.f;
    float carry = 0.f; bool done = !haveq;
    const int T_hi = (U.q_pos0 + 32 * U.nqw - 1) >> 6;
    volatile LAS unsigned* flags = (volatile LAS unsigned*)(F.lds + AT_FLAGS);
#define SB_STAGE(t) do { if (U.ck && 64 * (t) < PAST) { at_stage_f32(F.lds + AT_K0 + ((t) & 1) * 16384, U.ck + (size_t)(t) * 64 * 1024 + U.head * 128, wave, lane); \
                                                          at_stage_f32(F.lds + AT_V0 + ((t) & 1) * 16384, U.cv + (size_t)(t) * 64 * 1024 + U.head * 128, wave, lane); } \
        else { at_stage(F.lds + AT_K0 + ((t) & 1) * 16384, Kb + (size_t)(t) * 64 * 1024, wave, lane); at_stage(F.lds + AT_V0 + ((t) & 1) * 16384, Vb + (size_t)(t) * 64 * 1024, wave, lane); } } while (0)
    SB_STAGE(T_hi);
    VM_WAIT(); __syncthreads();
    const float C2 = 0.08838834764831845f * 1.4426950408889634f;
    for (int T = T_hi; T >= 0; --T) {
        if (T > 0) SB_STAGE(T - 1);
        const int wq_max = U.q_pos0 + 32 * wave + 31;
        if (!done && 64 * T < wq_max) {
            const LAS unsigned char* kt = F.lds + AT_K0 + (T & 1) * 16384; const LAS unsigned char* vt = F.lds + AT_V0 + (T & 1) * 16384;
#pragma unroll
            for (int sub = 1; sub >= 0; --sub) {
                if (64 * T + 32 * sub >= wq_max) continue;
                f32x16 p = at_qk(kt, ko, sub, qf);
                const int kb0 = 64 * T + 32 * sub + 4 * hi;
                float x[16], zl[16];
#pragma unroll
                for (int r = 0; r < 16; ++r) { const int kp = kb0 + (r & 3) + 8 * (r >> 2); const bool ok = kp < qpos;
                    const float z = p[r] * C2; zl[r] = ok ? z : -__builtin_inff();
                    const float sp = fmaxf(z, 0.f) + __builtin_amdgcn_logf(1.f + __builtin_amdgcn_exp2f(-fabsf(z)));
                    x[r] = ok ? -sp : 0.f; }
                float S[4], Tq[4];
#pragma unroll
                for (int g = 0; g < 4; ++g) { S[g] = (x[4 * g] + x[4 * g + 1]) + (x[4 * g + 2] + x[4 * g + 3]); Tq[g] = xhalf(S[g]); }
                float B = 0.f, ga[4];
#pragma unroll
                for (int g = 3; g >= 0; --g) { ga[g] = B + (hi ? 0.f : Tq[g]); B += S[g] + Tq[g]; }
#pragma unroll
                for (int g = 0; g < 4; ++g) { float run = ga[g] + carry;
#pragma unroll
                    for (int i = 3; i >= 0; --i) { const int r = 4 * g + i; const float aft = run; run += x[r];
                        p[r] = __builtin_amdgcn_exp2f(zl[r] + x[r] + aft); } }
                carry += B;
                at_pv(o, vt, vo, sub, p);
            }
            done = __all(carry < -150.f);
        }
        if (lane == 0) flags[(T & 1) * 8 + wave] = done ? 0u : 1u;
        VM_WAIT(); __syncthreads();
        unsigned any = 0;
#pragma unroll
        for (int w = 0; w < 8; ++w) any |= flags[(T & 1) * 8 + w];
        if (!any) break;
    }
#undef SB_STAGE
    if (haveq) at_store_o(o, 1.f, (bf16*)(F.ws + WS_OSB), tok, U.head, lane);
    __syncthreads();
}

__device__ __forceinline__ int t5_bucket(int rel) {
    const int n = rel < 0 ? -rel : rel;
    const int large = 8 + (n >= 15) + (n >= 27) + (n >= 50) + (n >= 91) + (n >= 166) + (n >= 305) + (n >= 559);
    return (rel > 0 ? 16 : 0) + (n < 8 ? n : large);
}
__device__ __forceinline__ void at_stage_mask(LAS unsigned char* dst, const unsigned* mblk, int mpitch, int T, int nq, int tid, int wave) {
    const int q = (tid >> 1) < nq ? (tid >> 1) : 0;
    __builtin_amdgcn_global_load_lds(mblk + (size_t)q * mpitch + 2 * T + (tid & 1), (LAS unsigned*)(dst + wave * 256), 4, 0, 0);
}
template <int MMODE> __device__ __forceinline__ void dsa_unit(Frame& F, const AttnUnit& U, const unsigned* mblk  , int mpitch, bf16* Oout) {
    const bf16* Kb = (const bf16*)(F.ws + WS_KSA) + (size_t)U.kv_base * 1024 + U.head * 128;
    const bf16* Vb = (const bf16*)(F.ws + WS_VSA) + (size_t)U.kv_base * 1024 + U.head * 128;
    bf16* QO = (bf16*)(F.ws + WS_QSA);
    const int lane = F.lane, wave = F.wave, ql = lane & 31, hi = lane >> 5;
    const bool haveq = wave < U.nqw;
    const int wv = haveq ? wave : 0;
    const int tok = U.q_tok0 + 32 * wv + ql, qpos = U.q_pos0 + 32 * wv + ql;
    const int lim_w = haveq ? (((U.q_pos0 + 32 * wv) >> 6) + 1) * 64 : 0;
    const int T_end = (((U.q_pos0 + 32 * U.nqw - 1) >> 6) + 1);
    int ko[8], vo[4][2]; at_koffs(lane, ko); at_voffs(lane, vo);
    bf16x8 qf[8]; at_load_q(qf, QO, tok, U.head, lane);
    f32x16 o[4];
#pragma unroll
    for (int mt = 0; mt < 4; ++mt)
#pragma unroll
        for (int r = 0; r < 16; ++r) o[mt][r] = 0.f;
    float m2 = -1e30f, l = 0.f;
    unsigned dbg_chk = 0u;
    LAS float* tab = (LAS float*)(F.lds + DS_TAB);
    if (F.tid < 32) tab[F.tid] = F.in[I_REL][F.tid * 8 + U.head] * 1.4426950408889634f;
    LAS float* tabn = (LAS float*)(F.lds + DS_TABN);
    for (int i = F.tid; i < DS_TABN_N; i += NWAVES * 64) tabn[i] = F.in[I_REL][t5_bucket(i - DS_TABN_OFF) * 8 + U.head] * 1.4426950408889634f;
#define DS_STAGE(t) do { at_stage(F.lds + DS_K0 + ((t) & 3) * 16384, Kb + (size_t)(t) * 64 * 1024, wave, lane); at_stage(F.lds + DS_V0 + ((t) & 3) * 16384, Vb + (size_t)(t) * 64 * 1024, wave, lane); \
        at_stage_mask(F.lds + DS_MASK + ((t) & 3) * 2048, mblk, mpitch, (t), 32 * U.nqw, F.tid, wave); } while (0)
    DS_STAGE(0); if (T_end > 1) DS_STAGE(1); if (T_end > 2) DS_STAGE(2);
    if (T_end > 2) asm volatile("s_waitcnt vmcnt(10)" ::: "memory"); else if (T_end > 1) asm volatile("s_waitcnt vmcnt(5)" ::: "memory"); else asm volatile("s_waitcnt vmcnt(0)" ::: "memory");
    asm volatile("s_waitcnt lgkmcnt(0)" ::: "memory"); __builtin_amdgcn_s_barrier(); asm volatile("" ::: "memory");
    const float tabl = tab[ql];
    const float b15 = tab[15];
    const float C2 = 0.08838834764831845f * 1.4426950408889634f;
    for (int T = 0; T < T_end; ++T) {
        if (T + 3 < T_end) DS_STAGE(T + 3);
        if (64 * T < lim_w) {
            const LAS unsigned char* kt = F.lds + DS_K0 + (T & 3) * 16384; const LAS unsigned char* vt = F.lds + DS_V0 + (T & 3) * 16384;
            const v2u mw = MMODE == 1 ? (v2u){0xffffffffu, 0xffffffffu} : *(const LAS v2u*)(F.lds + DS_MASK + (T & 3) * 2048 + (32 * wv + ql) * 8);
            const bool far = (64 * T + 63) <= (U.q_pos0 + 32 * wv) - 559;
#pragma unroll
            for (int sub = 0; sub < 2; ++sub) {
                const unsigned wbits = (sub ? mw.y : mw.x) >> (4 * hi);
                f32x16 p = at_qk(kt, ko, sub, qf);
                if (far) {
                    const bool has = m2 > -1e29f; const float bm = b15 - (has ? m2 : 0.f);
                    float xm[16], umax;
#pragma unroll
                    for (int r = 0; r < 16; ++r) xm[r] = fmaf(p[r], C2, bm);
                    umax = xm[0];
#pragma unroll
                    for (int r = 1; r < 16; ++r) umax = fmaxf(umax, xm[r]);
                    umax = fmaxf(umax, xhalf(umax));
                    const unsigned wsel = wbits & 0x0f0f0f0fu, wany = wsel | (unsigned)__shfl_xor((int)wsel, 32);
                    unsigned pw[8];
#pragma unroll
                    for (int k = 0; k < 8; ++k) { const int c0 = 2 * (k & 1) + 8 * (k >> 1);
                        const unsigned mlo = (unsigned)__builtin_amdgcn_sbfe((int)wbits, c0, 1), mhi = (unsigned)__builtin_amdgcn_sbfe((int)wbits, c0 + 1, 1);
                        pw[k] = pk2(__builtin_amdgcn_exp2f(xm[2 * k]), __builtin_amdgcn_exp2f(xm[2 * k + 1])) & __builtin_amdgcn_perm(mhi, mlo, 0x05040100u); }
                    if (!__any(umax > 8.f || (!has && wany != 0u))) {
#pragma unroll
                        for (int k = 0; k < 8; ++k) l = __builtin_amdgcn_fdot2_f32_bf16(__builtin_bit_cast(bf16x2_, pw[k]), __builtin_bit_cast(bf16x2_, 0x3f803f80u), l, false);
                        at_pv_w(o, vt, vo, sub, pw);
                        continue;
                    }
                }
                float pmax = -__builtin_inff();
                if (far) {
#pragma unroll
                    for (int r = 0; r < 16; ++r) { const bool sel = (wbits >> ((r & 3) + 8 * (r >> 2))) & 1u; p[r] = sel ? fmaf(p[r], C2, b15) : -__builtin_inff(); pmax = fmaxf(pmax, p[r]); }
                } else {
                    int ti = 64 * T + 32 * sub + 4 * hi - qpos + DS_TABN_OFF; ti = ti < 0 ? 0 : (ti > DS_TABN_N - 28 ? DS_TABN_N - 28 : ti);
                    const LAS float* tb = tabn + ti;
#pragma unroll
                    for (int r = 0; r < 16; ++r) { const bool sel = (wbits >> ((r & 3) + 8 * (r >> 2))) & 1u;
                        const float bias = tb[(r & 3) + 8 * (r >> 2)];
                        p[r] = sel ? fmaf(p[r], C2, bias) : -__builtin_inff(); pmax = fmaxf(pmax, p[r]); }
                }
                pmax = fmaxf(pmax, xhalf(pmax));
                if (!__all(pmax - m2 <= 8.f)) {
                    const float mn = fmaxf(m2, pmax), alpha = __builtin_amdgcn_exp2f(m2 - mn);
#pragma unroll
                    for (int mt = 0; mt < 4; ++mt)
#pragma unroll
                        for (int r = 0; r < 16; ++r) o[mt][r] *= alpha;
                    l *= alpha; m2 = mn;
                }
                float ps = 0.f;
#pragma unroll
                for (int r = 0; r < 16; ++r) { p[r] = __builtin_amdgcn_exp2f(p[r] - m2); ps += p[r]; }
                l += ps;
                at_pv(o, vt, vo, sub, p);
            }
        }
        { const int after = T_end - 2 - T;
          if (after >= 2) asm volatile("s_waitcnt vmcnt(10)" ::: "memory"); else if (after == 1) asm volatile("s_waitcnt vmcnt(5)" ::: "memory"); else asm volatile("s_waitcnt vmcnt(0)" ::: "memory"); }
        asm volatile("s_waitcnt lgkmcnt(0)" ::: "memory"); __builtin_amdgcn_s_barrier(); asm volatile("" ::: "memory");
    }
#undef DS_STAGE
    const float lt = l + xhalf(l);
    if (haveq) at_store_o(o, lt > 0.f ? 1.f / lt : 0.f, Oout, tok, U.head, lane);
    __syncthreads();
}
typedef float f32x2i __attribute__((ext_vector_type(2)));
typedef int i32x16i __attribute__((ext_vector_type(16)));
constexpr int IX_CAP = 512, IX_BITS = 131072;
__device__ __forceinline__ unsigned f2key(float f) { const unsigned u = __float_as_uint(f); return u ^ ((unsigned)((int)u >> 31) | 0x80000000u); }
__device__ __forceinline__ int ix_select(LAS unsigned* bk, LAS unsigned short* bi, int n, int nbits, int lane, unsigned& bound_out) {
    unsigned key[8]; unsigned idx[8];
#pragma unroll
    for (int i = 0; i < 8; ++i) { const int e = lane + 64 * i; const bool v = e < n; key[i] = v ? bk[e] : 0u; idx[i] = v ? (unsigned)bi[e] : 0u; }
    unsigned prefix = 0u;
    for (int bit = 31; bit >= 32 - nbits; --bit) { const unsigned cand = prefix | (1u << bit); int c = 0;
#pragma unroll
        for (int i = 0; i < 8; ++i) c += __popcll(__ballot(key[i] >= cand));
        if (c >= 256) prefix = cand; }
    const unsigned long long lt = (1ull << lane) - 1ull;
    bool keep[8];
    if (nbits == 32) {
        int ngt = 0;
#pragma unroll
        for (int i = 0; i < 8; ++i) ngt += __popcll(__ballot(key[i] > prefix));
        const int need = 256 - ngt; int eqbase = 0;
#pragma unroll
        for (int i = 0; i < 8; ++i) { const bool eq = (key[i] == prefix) && (key[i] != 0u); const unsigned long long m = __ballot(eq);
            const int rank = eqbase + __popcll(m & lt); keep[i] = (key[i] > prefix) || (eq && rank < need); eqbase += __popcll(m); }
        bound_out = prefix;
    } else {
#pragma unroll
        for (int i = 0; i < 8; ++i) keep[i] = (key[i] >= prefix) && (key[i] != 0u);
        bound_out = prefix - 1u;
    }
    int base = 0;
#pragma unroll
    for (int i = 0; i < 8; ++i) { const unsigned long long m = __ballot(keep[i]); const int pos = base + __popcll(m & lt);
        if (keep[i]) { bk[pos] = key[i]; bi[pos] = (unsigned short)idx[i]; } base += __popcll(m); }
    return base;
}
struct CvState { f32x4 a, b; int k; };
__device__ __forceinline__ bool cv_step(Frame& F, CvState& cv) {
    const size_t NGT = (size_t)F.G * (NWAVES * 64), gt = (size_t)F.c * (NWAVES * 64) + F.tid; const int KT = (int)(((size_t)8388608 + NGT - 1) / NGT);
    if (cv.k > 2 * KT) return false;
    if (cv.k > 0) { const int kk = cv.k - 1; const bool t = kk >= KT; const size_t i = gt + (size_t)(t ? kk - KT : kk) * NGT;
        if (i < (size_t)8388608) { const size_t e = i * 8, sq = e >> 21, rem = e & 2097151;
            v4u o; o.x = pk2(cv.a[0], cv.a[1]); o.y = pk2(cv.a[2], cv.a[3]); o.z = pk2(cv.b[0], cv.b[1]); o.w = pk2(cv.b[2], cv.b[3]);
            __builtin_nontemporal_store(o, (v4u*)((bf16*)(F.ws + (t ? WS_VSA : WS_KSA)) + ((size_t)MP + sq * SKV) * 1024 + rem)); } }
    if (cv.k < 2 * KT) { const int kk = cv.k; const bool t = kk >= KT; const size_t i = gt + (size_t)(t ? kk - KT : kk) * NGT;
        if (i < (size_t)8388608) { const float* src = (t ? F.in[I_CSAV] : F.in[I_CSAK]) + i * 8; cv.a = *(const GAS f32x4*)src; cv.b = *(const GAS f32x4*)(src + 4); } }
    ++cv.k;
    return true;
}
__device__ __forceinline__ void ix_unit(Frame& F, int kv_base, int q_tok0, int lim, unsigned* mask0, int mpitch, CvState& cv) {
    const int lane = F.lane, wave = F.wave, kl = lane & 31, hh = lane >> 5;
    const bf16* QIX = (const bf16*)(F.ws + WS_QIX); const float* WIX = (const float*)(F.ws + WS_WIX);
    const bf16* kp = (const bf16*)(F.ws + WS_KIX) + (size_t)kv_base * 64 + kl * 64 + 8 * hh;
    bf16x8 qa[2][4]; float wvv[2][16];
#pragma unroll
    for (int p = 0; p < 2; ++p) {
        const int g = kl >> 3, h1 = (kl >> 2) & 1, i = kl & 3;
        const bf16* qp = QIX + (size_t)(q_tok0 + 4 * wave + 2 * p + h1) * 1024 + (4 * g + i) * 64 + 8 * hh;
#pragma unroll
        for (int ks = 0; ks < 4; ++ks) qa[p][ks] = *(const GAS bf16x8*)(qp + 16 * ks);
        const float* wp = WIX + (size_t)(q_tok0 + 4 * wave + 2 * p + hh) * 16;
#pragma unroll
        for (int r4 = 0; r4 < 4; ++r4) { const f32x4 w4 = *(const GAS f32x4*)(wp + 4 * r4);
#pragma unroll
            for (int j = 0; j < 4; ++j) wvv[p][4 * r4 + j] = w4[j] * 0.03125f; }
    }
    int cnt0 = 0, cnt1 = 0, cnt2 = 0, cnt3 = 0; unsigned bound[2] = {0u, 0u};
    LAS unsigned char* wb = F.lds + wave * 12288;
    const int nsubs = lim >> 5;
#define IX_LD(KB, SUB) do { _Pragma("unroll") for (int ks_ = 0; ks_ < 4; ++ks_) KB[ks_] = *(const GAS bf16x8*)(kp + (size_t)(SUB) * 2048 + 16 * ks_); } while (0)
#define IX_MF(dst, P, KB) do { _Pragma("unroll") for (int r_ = 0; r_ < 16; ++r_) dst[r_] = 0.f; _Pragma("unroll") for (int ks_ = 0; ks_ < 4; ++ks_) dst = MFMA32(qa[P][ks_], KB[ks_], dst); } while (0)
#define IX_PROC(A, P, SUB) do { float s_; { i32x16i iv_ = __builtin_bit_cast(i32x16i, A); i32x16i zz_; _Pragma("unroll") for (int r_ = 0; r_ < 16; ++r_) zz_[r_] = 0; \
            iv_ = __builtin_elementwise_max(iv_, zz_); const f32x16 rl_ = __builtin_bit_cast(f32x16, iv_); f32x2i s2_ = {0.f, 0.f}; \
            _Pragma("unroll") for (int r_ = 0; r_ < 16; r_ += 2) { const f32x2i x_ = {rl_[r_], rl_[r_ + 1]}; const f32x2i w2_ = {wvv[P][r_], wvv[P][r_ + 1]}; s2_ = w2_ * x_ + s2_; } s_ = s2_.x + s2_.y; } \
        const unsigned kpos_ = (unsigned)(32 * (SUB) + kl); const unsigned key_ = f2key(s_); const bool pass_ = key_ > bound[P]; const unsigned long long m_ = __ballot(pass_); \
        if (m_) { const unsigned mlo_ = (unsigned)m_, mhi_ = (unsigned)(m_ >> 32); int& cA_ = (P == 0 ? cnt0 : cnt2); int& cB_ = (P == 0 ? cnt1 : cnt3); \
            const int pos_ = (hh ? cB_ : cA_) + __popc((hh ? mhi_ : mlo_) & ((1u << kl) - 1u)); LAS unsigned char* qb_ = wb + (2 * P + hh) * 3072; \
            if (pass_) { ((LAS unsigned*)qb_)[pos_] = key_; ((LAS unsigned short*)(qb_ + 2048))[pos_] = (unsigned short)kpos_; } \
            cA_ += __popc(mlo_); cB_ += __popc(mhi_); \
            if (cA_ > IX_CAP - 32) { unsigned b_; LAS unsigned char* q0_ = wb + (2 * P) * 3072; cA_ = ix_select((LAS unsigned*)q0_, (LAS unsigned short*)(q0_ + 2048), cA_, 12, lane, b_); \
                if (cA_ > 384) cA_ = ix_select((LAS unsigned*)q0_, (LAS unsigned short*)(q0_ + 2048), cA_, 32, lane, b_); if (!hh) bound[P] = b_; } \
            if (cB_ > IX_CAP - 32) { unsigned b_; LAS unsigned char* q1_ = wb + (2 * P + 1) * 3072; cB_ = ix_select((LAS unsigned*)q1_, (LAS unsigned short*)(q1_ + 2048), cB_, 12, lane, b_); \
                if (cB_ > 384) cB_ = ix_select((LAS unsigned*)q1_, (LAS unsigned short*)(q1_ + 2048), cB_, 32, lane, b_); if (hh) bound[P] = b_; } } } while (0)
#define IX_STEP(KCUR, KFILL, SUB) do { IX_LD(KFILL, (SUB) + 1);          \
        f32x16 a0_, a1_; IX_MF(a0_, 0, KCUR); IX_MF(a1_, 1, KCUR); IX_PROC(a0_, 0, SUB); IX_PROC(a1_, 1, SUB); } while (0)
    bf16x8 kA[4], kB[4];
    IX_LD(kA, 0);
    for (int sub = 0; sub < nsubs; sub += 2) { IX_STEP(kA, kB, sub); IX_STEP(kB, kA, sub + 1); if ((sub & 2) == 0) cv_step(F, cv); }
#undef IX_STEP
#undef IX_LD
#undef IX_MF
#undef IX_PROC
    LAS unsigned* bits = (LAS unsigned*)(F.lds + IX_BITS + wave * 2048);
    const int nw = lim >> 5;
#pragma unroll 1
    for (int q4 = 0; q4 < 4; ++q4) {
        int n = q4 == 0 ? cnt0 : q4 == 1 ? cnt1 : q4 == 2 ? cnt2 : cnt3;
        LAS unsigned char* qb = wb + q4 * 3072; unsigned b;
        if (n > 256) n = ix_select((LAS unsigned*)qb, (LAS unsigned short*)(qb + 2048), n, 32, lane, b);
        for (int w = lane; w < nw; w += 64) bits[w] = 0u;
        for (int e = lane; e < n; e += 64) { const unsigned ix = ((LAS unsigned short*)(qb + 2048))[e]; __hip_atomic_fetch_or(bits + (ix >> 5), 1u << (ix & 31), __ATOMIC_RELAXED, __HIP_MEMORY_SCOPE_WORKGROUP); }
        unsigned* mr = mask0 + (size_t)(4 * wave + q4) * mpitch;
        for (int w = lane; w < nw; w += 64) mr[w] = bits[w];
    }
}
constexpr int N_PHASES = 12;
struct Args { const float* in[25]; float* out; unsigned char* ws; int ph_lo, ph_hi; };
__global__ void __launch_bounds__(NWAVES * 64, 2) fwd_kernel(Args args) {
    extern __shared__ __attribute__((aligned(16))) unsigned char lds[];
    Frame F;
    F.lds = (LAS unsigned char*)lds; F.ws = args.ws; F.out = args.out;
    F.tid = threadIdx.x; F.lane = F.tid & 63; F.wave = __builtin_amdgcn_readfirstlane(F.tid >> 6);
    F.G = gridDim.x; F.c = blockIdx.x;
#pragma unroll
    for (int i = 0; i < 25; ++i) F.in[i] = args.in[i];
    volatile LAS unsigned* MISC = (volatile LAS unsigned*)(F.lds + MISC_OFF);
    if (F.tid < 64) MISC[F.tid] = 0u;
    __syncthreads();
    unsigned* ctl = (unsigned*)(F.ws + WS_CTL);
    XcdBarrier bar; bar.bar = ctl + CW_BAR; bar.x = 0; bar.st = nullptr;
    const int lo = args.ph_lo, hi = args.ph_hi;
    const bool one_launch = (hi - lo) > 1;
    if (one_launch) bar = xcd_barrier_post(ctl + CW_BAR, MISC + 8);
#define IN(k) (lo <= (k) && (k) < hi)
#define SEAM(k) do { if (IN(k) && IN((k) + 1)) xcd_barrier(bar); } while (0)

    if (IN(0)) { p0_prologue(F); } SEAM(0);
    if (IN(1)) { norm_mod_rows(F, F.in[I_XP], F.in[I_XS], F.in[I_GMIX], 0, 1, 0, MT, F.c, F.G); } SEAM(1);
    if (IN(2)) {
      {
        pg8::Gemm g{(const bf16*)(F.ws + WS_HB), (const bf16*)(F.ws + WS_WCAT), MT, NCAT, DM}; pg8::StaticOrder S; S.init(MT, NCAT, F.G, F.c);
        pg8::EpiG1 E{F.ws, F.out};
        pg8::gemm_phase<pg8::EpiG1, pg8::StaticOrder, true, true>(F.lds + RING_OFF, g, S, E);
      }
    } SEAM(2);
    if (IN(3)) {
      {
        CvState cv; cv.k = 0; cv.a = (f32x4){0.f, 0.f, 0.f, 0.f}; cv.b = cv.a;
        const int sb_n = (F.G == 256) ? (F.c < 64 ? 2 : 6) : 0, sb_0 = (F.G == 256) ? (F.c < 64 ? 2 * F.c : 128 + 6 * (F.c - 64)) : F.c;
        for (int u = sb_0, k_ = 0; u < 1280 && (F.G != 256 || k_ < sb_n); u += (F.G == 256 ? 1 : F.G), ++k_) {
            AttnUnit U;
            if (u < 1024) { const int b = u >> 9, qb = u & 63; U.kv_base = b * SEQ; U.q_tok0 = b * SEQ + 256 * qb; U.q_pos0 = 256 * qb; U.nqw = 8; U.head = (u >> 6) & 7; U.ck = nullptr; U.cv = nullptr; }
            else { const int v = u - 1024, s = v >> 3; U.kv_base = MP + s * SKV; U.q_tok0 = MP + 64 * s; U.q_pos0 = PAST; U.nqw = 2; U.head = v & 7;
                   U.ck = F.in[I_CSBK] + (size_t)s * PAST * 1024; U.cv = F.in[I_CSBV] + (size_t)s * PAST * 1024; }
            sb_unit(F, U);
        }
        for (int j = F.c; j < 512; j += F.G) {
            const int b = j >> 8, jj = j & 255;
#pragma unroll 1
            for (int k = 0; k < 2; ++k) { const int hc = k ? 511 - jj : jj, q0 = 32 * hc;
                ix_unit(F, b * SEQ, b * SEQ + q0, 64 * ((hc >> 1) + 1), (unsigned*)(F.ws + WS_MASKP) + (size_t)(b * SEQ + q0) * MASKP_PITCH, MASKP_PITCH, cv); }
        }
        for (int v = F.c; v < 64; v += F.G) { const int s = v >> 1, half = v & 1;
            ix_unit(F, MP + s * SKV, MP + 64 * s + 32 * half, SKV, (unsigned*)(F.ws + WS_MASKS) + (size_t)(64 * s + 32 * half) * MASKS_PITCH, MASKS_PITCH, cv); }
        for (int g_ = 0; g_ < 65536; ++g_) if (!cv_step(F, cv)) break;
      }
    } SEAM(3);
    if (IN(4)) {
      {
        for (int it = F.c; it < 512; it += F.G) {
            const int pu = (F.G == 256) ? ((2 * (it & 7) + (it >> 8)) << 5) + ((it >> 3) & 31) : it;
            const int b = pu >> 8, i = pu & 31;
#pragma unroll 1
            for (int k = 0; k < 2; ++k) { const int qb = k ? 63 - i : i;
                AttnUnit U; U.kv_base = b * SEQ; U.q_tok0 = b * SEQ + 256 * qb; U.q_pos0 = 256 * qb; U.nqw = 8; U.head = (pu >> 5) & 7; U.ck = nullptr; U.cv = nullptr;
                dsa_unit<0>(F, U, (const unsigned*)(F.ws + WS_MASKP) + (size_t)(b * SEQ + 256 * qb) * MASKP_PITCH, MASKP_PITCH, (bf16*)(F.ws + WS_OSA)); }
        }
        for (int v = F.c; v < 256; v += F.G) { const int s = v >> 3;
            AttnUnit U; U.kv_base = MP + s * SKV; U.q_tok0 = MP + 64 * s; U.q_pos0 = PAST; U.nqw = 2; U.head = v & 7; U.ck = nullptr; U.cv = nullptr;
            dsa_unit<0>(F, U, (const unsigned*)(F.ws + WS_MASKS) + (size_t)(64 * s) * MASKS_PITCH, MASKS_PITCH, (bf16*)(F.ws + WS_OSA)); }
      }
    } SEAM(4);
    if (IN(5)) {
      {
        { pg8::Gemm g{(const bf16*)(F.ws + WS_OSB), (const bf16*)(F.ws + WS_WBRSB), MT, DM, WSB}; pg8::StaticOrder S; S.init(MT, DM, F.G, F.c);
          pg8::EpiBr1 E{F.ws}; pg8::gemm_phase<pg8::EpiBr1, pg8::StaticOrder, true, true>(F.lds + RING_OFF, g, S, E); }
        VM_WAIT(); __syncthreads();
        { pg8::Gemm g{(const bf16*)(F.ws + WS_OSA), (const bf16*)(F.ws + WS_WBRSA), MT, DM, WSB}; pg8::StaticOrder S; S.init(MT, DM, F.G, F.c);
          pg8::EpiBr2 E{F.ws}; pg8::gemm_phase<pg8::EpiBr2, pg8::StaticOrder, true, true>(F.lds + RING_OFF, g, S, E); }
      }
    } SEAM(5);
    const bool split = one_launch && F.G > 64;
    constexpr int P7_EARLY = 16384;
    if (IN(6)) {
      {
        pg8::Gemm g{(const bf16*)(F.ws + WS_MRG), (const bf16*)(F.ws + WS_WOUT), MT, DM, DM};
        pg8::EpiRes E{F.in[I_XP], F.in[I_XS], (float*)(F.ws + WS_XMID), (const float*)(F.ws + WS_MOD), 2};
        { pg8::StaticOrder S; S.init(split ? MP : MT, DM, F.G, F.c); pg8::gemm_phase<pg8::EpiRes, pg8::StaticOrder, true, true>(F.lds + RING_OFF, g, S, E); }
        if (split) {
            VM_WAIT(); __syncthreads();
            if (F.tid == 0) xcd_count_in(bar, ctl + CW_P6L, ctl + CW_P6);
            if (F.c < 64) { pg8::TailOrder S{MP / 256, DM / 256, F.c}; pg8::gemm_phase<pg8::EpiRes, pg8::TailOrder, true, true>(F.lds + RING_OFF, g, S, E); }
            else {
                if (F.tid == 0) { XB_SPIN(xb_ld(ctl + CW_P6) < (unsigned)F.G, bar.bar); __builtin_amdgcn_fence(__ATOMIC_ACQUIRE, "agent"); VM_WAIT(); }
                __syncthreads();
                norm_mod_rows(F, (const float*)(F.ws + WS_XMID), (const float*)(F.ws + WS_XMID) + (size_t)MP * DM, F.in[I_GFFN], 3, 4, 0, P7_EARLY, F.c - 64, F.G - 64);
            }
        }
      }
    } SEAM(6);
    if (IN(7)) { norm_mod_rows(F, (const float*)(F.ws + WS_XMID), (const float*)(F.ws + WS_XMID) + (size_t)MP * DM, F.in[I_GFFN], 3, 4, split ? P7_EARLY : 0, MT, F.c, F.G); } SEAM(7);
    if (IN(8)) {
      {
        pg8::Gemm g{(const bf16*)(F.ws + WS_HB), (const bf16*)(F.ws + WS_WUP), MT, NUP, DM}; pg8::StaticOrder S; S.init(MT, NUP, F.G, F.c);
        pg8::EpiUpConv E{F.ws, F.out, F.in[I_CONVW], F.in[I_CONVB], F.in[I_CONVST], (LAS float*)(F.lds + HALO_OFF)};
        pg8::gemm_phase<pg8::EpiUpConv, pg8::StaticOrder, true, true>(F.lds + RING_OFF, g, S, E);
      }
    } SEAM(8);
    if (IN(9)) { conv_fix(F); } SEAM(9);
    if (IN(10)) {
      {
        pg8::Gemm g{(const bf16*)(F.ws + WS_ACT), (const bf16*)(F.ws + WS_WDOWN), MT, DM, DFF};
        pg8::EpiRes E{(const float*)(F.ws + WS_XMID), (const float*)(F.ws + WS_XMID) + (size_t)MP * DM, F.out + O_Y, (const float*)(F.ws + WS_MOD), 5};
        { pg8::StaticOrder S; S.init(split ? MP : MT, DM, F.G, F.c); pg8::gemm_phase<pg8::EpiRes, pg8::StaticOrder, true, true>(F.lds + RING_OFF, g, S, E); }
        if (split) {
            VM_WAIT(); __syncthreads();
            if (F.tid == 0) xcd_count_in(bar, ctl + CW_P10L, ctl + CW_P10);
            if (F.c < 64) { pg8::TailOrder S{MP / 256, DM / 256, F.c}; pg8::gemm_phase<pg8::EpiRes, pg8::TailOrder, true, true>(F.lds + RING_OFF, g, S, E); }
            else {
                if (F.tid == 0) { XB_SPIN(xb_ld(ctl + CW_P10) < (unsigned)F.G, bar.bar); __builtin_amdgcn_fence(__ATOMIC_ACQUIRE, "agent"); VM_WAIT(); }
                __syncthreads();
                final_norm_rows(F, 0, MP, F.c - 64, F.G - 64);
            }
        }
      }
    } SEAM(10);
    if (IN(11)) { final_norm_rows(F, split ? MP : 0, MT, F.c, F.G); }
#undef IN
#undef SEAM
}

extern "C" void kernel_launch(void* const* d_in, const int* in_sizes, int n_in, void* d_out, int out_size, void* d_ws, size_t ws_size, hipStream_t stream) {
    static int grid = 0;
    if (grid == 0) {
        if (n_in != 25 || in_sizes[0] != MP * DM || (size_t)out_size != O_END || ws_size < WS_END) {
            fprintf(stderr, "kernel_launch: built for 25 inputs, out of %zu floats, >= %zu bytes of workspace; got n_in %d, in0 %d, out %d, ws %zu; nothing launched\n", (size_t)O_END, (size_t)WS_END, n_in, n_in > 0 ? in_sizes[0] : -1, out_size, ws_size); grid = -1; return; }
        int dev = 0, cus = 0, per_cu = 0;
        if (hipGetDevice(&dev) != hipSuccess || hipDeviceGetAttribute(&cus, hipDeviceAttributeMultiprocessorCount, dev) != hipSuccess) { fprintf(stderr, "kernel_launch: device query failed\n"); grid = -1; return; }
        if (hipFuncSetAttribute((const void*)fwd_kernel, hipFuncAttributeMaxDynamicSharedMemorySize, LDS_BYTES) != hipSuccess) { fprintf(stderr, "kernel_launch: hipFuncSetAttribute failed\n"); grid = -1; return; }
        if (hipOccupancyMaxActiveBlocksPerMultiprocessor(&per_cu, (const void*)fwd_kernel, NWAVES * 64, LDS_BYTES) != hipSuccess || per_cu < 1)
            fprintf(stderr, "kernel_launch: note: occupancy query reports %d workgroups per CU\n", per_cu);
        (void)hipGetLastError();
        grid = cus;
    }
    if (grid < 0) return;
    if (hipMemsetAsync((char*)d_ws + WS_CTL, 0, CTL_ZERO_BYTES, stream) != hipSuccess) { fprintf(stderr, "kernel_launch: memset failed\n"); return; }
    Args a{};
    for (int i = 0; i < 25; ++i) a.in[i] = (const float*)d_in[i];
    a.out = (float*)d_out; a.ws = (unsigned char*)d_ws;
    a.ph_lo = 0; a.ph_hi = N_PHASES;
    hipLaunchKernelGGL(fwd_kernel, dim3(grid), dim3(NWAVES * 64), LDS_BYTES, stream, a);
    const hipError_t le = hipPeekAtLastError();
    if (le != hipSuccess) fprintf(stderr, "kernel_launch: launch failed: %s\n", hipGetErrorName(le));
}
```

```cpp
#include <hip/hip_runtime.h>
#include <cstdio>
#include <cstdint>

constexpr int DM = 2048, SEQ = 16384, NSAMP = 32, DSEQ = 64, PAST = 2048, SKV = PAST + DSEQ;
constexpr int MP = 2 * SEQ, MS = NSAMP * DSEQ, MT = MP + MS;
constexpr int KVR = MP + NSAMP * SKV;
constexpr int NCAT = 11520, NGATE0 = 7424, DFF = 5632, NUP = 2 * DFF, WSB = 1024;
constexpr float EPS = 1e-6f;
constexpr size_t O_Y = 0, O_PSBK = 71303168, O_PSBV = 104857600, O_PSAK = 138412032, O_PSAV = 171966464, O_PIDX = 205520896, O_PCONV = 207618048,
                 O_SSBK = 207640576, O_SSBV = 209737728, O_SSAK = 211834880, O_SSAV = 213932032, O_SIDX = 216029184, O_SCONV = 216160256, O_END = 216520704;
constexpr size_t MiB = 1u << 20;
constexpr size_t WS_CTL = 0, CTL_ZERO_BYTES = 1 * MiB;
constexpr size_t WS_MOD = 1 * MiB;
constexpr size_t WS_WDOWN = 3 * MiB;
constexpr size_t WS_G = 25 * MiB;
constexpr size_t WS_XMID = WS_G;
constexpr size_t WS_KSB = 297 * MiB, WS_VSB = 493 * MiB, WS_KSA = 689 * MiB, WS_VSA = 885 * MiB;
constexpr size_t WS_TMP = 297 * MiB;
constexpr size_t WS_ACT = 297 * MiB;
constexpr size_t WS_TAIL = 700 * MiB;
constexpr size_t WS_HEAD = 708 * MiB;
constexpr size_t WS_HB = 1081 * MiB;
constexpr size_t WS_QSB = 1217 * MiB, WS_QSA = 1285 * MiB, WS_QIX = 1353 * MiB;
constexpr size_t WS_OSB = WS_HB, WS_OSA = WS_HB + 68 * MiB;
constexpr size_t WS_MRG = WS_QSB;
constexpr size_t WS_KIX = 1421 * MiB;
constexpr size_t WS_WIX = 1434 * MiB;
constexpr size_t WS_MASKP = 1437 * MiB;
constexpr size_t WS_MASKS = 1501 * MiB;
constexpr size_t WS_WCAT = 1502 * MiB;
constexpr size_t WS_WBRSB = 1547 * MiB, WS_WBRSA = 1551 * MiB, WS_WOUT = 1555 * MiB, WS_WUP = 1563 * MiB;
constexpr size_t WS_END = 1607 * MiB;
static_assert(WS_ACT + (size_t)MT * DFF * 2 <= WS_TAIL && WS_TAIL + (size_t)128 * 44 * 2 * 128 * 4 <= WS_HEAD && WS_HEAD + (size_t)128 * 44 * 4 * 128 * 4 <= WS_HB && WS_VSA + (size_t)KVR * 2048 <= WS_HB, "ws map");
constexpr int MASKP_PITCH = 512, MASKS_PITCH = 96;
constexpr int CW_BAR = 4096, CW_P10 = 8192, CW_P6 = 8256, CW_P6L = 9216, CW_P10L = 10240;
constexpr int RING_OFF = 0, RING_BYTES = 131072;
constexpr int LDS_BYTES = 163840;
constexpr int HALO_OFF = RING_BYTES;
constexpr int MISC_OFF = LDS_BYTES - 256;

#define GAS __attribute__((address_space(1)))
#define LAS __attribute__((address_space(3)))
typedef unsigned short bf16;
typedef unsigned v4u __attribute__((ext_vector_type(4)));
typedef unsigned v2u __attribute__((ext_vector_type(2)));
typedef float f32x4 __attribute__((ext_vector_type(4)));
typedef float f32x16 __attribute__((ext_vector_type(16)));
typedef short bf16x8 __attribute__((ext_vector_type(8)));
typedef short s16x4 __attribute__((ext_vector_type(4)));
#define LDS_WAIT() asm volatile("s_waitcnt lgkmcnt(0)" ::: "memory")
#define VM_WAIT() asm volatile("s_waitcnt vmcnt(0)" ::: "memory")
typedef float f32x2_ __attribute__((ext_vector_type(2)));
typedef __bf16 bf16x2_ __attribute__((ext_vector_type(2)));
__device__ __forceinline__ unsigned pk2(float lo, float hi) { const f32x2_ v = {lo, hi}; return __builtin_bit_cast(unsigned, __builtin_convertvector(v, bf16x2_)); }
__device__ __forceinline__ float bf2f(unsigned b16) { return __uint_as_float(b16 << 16); }
__device__ __forceinline__ float wave_sum(float v) {
#pragma unroll
    for (int o = 1; o < 64; o <<= 1) v += __shfl_xor(v, o);
    return v;
}
__device__ __forceinline__ float sigmoidf_(float x) { return __builtin_amdgcn_rcpf(1.f + __builtin_amdgcn_exp2f(-1.4426950408889634f * x)); }
__device__ __forceinline__ int mod_row(int row) { return row < MP ? (row >> 14) : 2 + ((row - MP) >> 6); }
__device__ __forceinline__ int kv_row(int row) { return row < MP ? row : MP + ((row - MP) >> 6) * SKV + PAST + ((row - MP) & 63); }
namespace pg8 {
#define PG8_LAS __attribute__((address_space(3)))
typedef unsigned short bf16_t;
typedef short bf16x8 __attribute__((ext_vector_type(8)));
typedef float f32x4 __attribute__((ext_vector_type(4)));
typedef unsigned u32x4 __attribute__((ext_vector_type(4)));
constexpr int BM = 256, BK = 64, HALF = 128, HTB = HALF * BK * 2  , STAGE_BYTES = 8 * HTB, NXCD = 8, WGM = 8;

__host__ __device__ __forceinline__ int lds_byte(int r, int c) { const int st = (r >> 4) * 2 + (c >> 5), rr = r & 15, cc = c & 31, ob = rr * 64 + cc * 2; return st * 1024 + (ob ^ (((ob >> 9) & 1) << 5)); }
__host__ __device__ __forceinline__ void stage_rc(int b, int& R, int& C) { const int st = b / 1024, sb = b % 1024, swz = sb ^ (((sb >> 9) & 1) << 5); R = (st >> 1) * 16 + swz / 64; C = (st & 1) * 32 + (swz % 64) / 2; }
__host__ __device__ __forceinline__ int perm32(int rho) { const int n = rho >> 4, i = rho & 15; return 8 * (i >> 2) + 4 * n + (i & 3); }

struct Unit { int pm, pn; };
struct Gemm { const bf16_t* A; const bf16_t* Bt; int M, N, K; };

struct StaticOrder {
    int nM, nN, nwg, G, c;
    __host__ __device__ void init(int M, int N, int G_, int c_) { nM = M / BM; nN = N / BM; nwg = nM * nN; G = G_; c = c_; }
    __host__ __device__ bool next(int i, Unit& u) const {
        const long L = (long)i * G + c; if (L >= nwg) return false;
        int wgid = (int)L; { const int q = nwg / NXCD, r = nwg % NXCD, xcd = wgid % NXCD, off = wgid / NXCD; wgid = (xcd < r ? xcd * (q + 1) : r * (q + 1) + (xcd - r) * q) + off; }
        const int nig = WGM * nN, gid = wgid / nig, fm = gid * WGM, gsz = (nM - fm) < WGM ? (nM - fm) : WGM;
        u.pm = fm + ((wgid % nig) % gsz); u.pn = (wgid % nig) / gsz; return true;
    }
    __device__ __forceinline__ void a_ready(const Unit&) const {}
    __device__ __forceinline__ void done(const Unit&) const {}
};
struct TailOrder {
    int pm0, nN, c;
    __host__ __device__ bool next(int i, Unit& u) const { if (i > 0 || c >= 8 * nN) return false; u.pm = pm0 + (c & 7); u.pn = c >> 3; return true; }
    __device__ __forceinline__ void a_ready(const Unit&) const {}
    __device__ __forceinline__ void done(const Unit&) const {}
};

__device__ __forceinline__ unsigned cvt_pk_bf16(float lo, float hi) { return ::pk2(lo, hi); }
__device__ __forceinline__ float sigm(float x) { return __builtin_amdgcn_rcpf(1.f + __builtin_amdgcn_exp2f(-1.4426950408889634f * x)); }
__device__ __forceinline__ u32x4 pack8bf(const f32x4 v0, const f32x4 v1) { u32x4 w; w.x = cvt_pk_bf16(v0[0], v0[1]); w.y = cvt_pk_bf16(v0[2], v0[3]); w.z = cvt_pk_bf16(v1[0], v1[1]); w.w = cvt_pk_bf16(v1[2], v1[3]); return w; }
__device__ __forceinline__ void unpack8bf(const u32x4 w, f32x4& a, f32x4& b) {
    a[0] = __uint_as_float(w.x << 16); a[1] = __uint_as_float(w.x & 0xffff0000u); a[2] = __uint_as_float(w.y << 16); a[3] = __uint_as_float(w.y & 0xffff0000u);
    b[0] = __uint_as_float(w.z << 16); b[1] = __uint_as_float(w.z & 0xffff0000u); b[2] = __uint_as_float(w.w << 16); b[3] = __uint_as_float(w.w & 0xffff0000u); }

struct EpiG1 {
    static constexpr bool PERM = true, AFTER_DRAIN = false;
    unsigned char* ws; float* out;
    __device__ __forceinline__ void operator()(const f32x4 (&acc)[2][2][4][2], const Unit& u, int wr, int wc, int fr, int fq) const {
        const int pn = u.pn, pm = u.pm; const bool samp = pm >= 128;
        const int colw = wc * 32 + 8 * fq, row0 = pm * BM + wr * 64 + fr;
        if (pn >= 29) {
            bf16_t* G = (bf16_t*)(ws + WS_G) + (pn - 29) * 256 + colw;
#pragma unroll
            for (int ai = 0; ai < 2; ++ai)
#pragma unroll
                for (int m = 0; m < 4; ++m) { bf16_t* rowp = G + (size_t)(row0 + ai * HALF + m * 16) * 4096;
#pragma unroll
                    for (int bj = 0; bj < 2; ++bj) { f32x4 v0 = acc[ai][bj][m][0], v1 = acc[ai][bj][m][1];
#pragma unroll
                        for (int j = 0; j < 4; ++j) { v0[j] = sigm(v0[j]); v1[j] = sigm(v1[j]); }
                        __builtin_nontemporal_store(pack8bf(v0, v1), (u32x4*)(rowp + bj * HALF)); } }
            return;
        }
        if (pn == 28) {
            if (colw >= 80) return;
#pragma unroll
            for (int ai = 0; ai < 2; ++ai)
#pragma unroll
                for (int m = 0; m < 4; ++m) { const int row = row0 + ai * HALF + m * 16; const f32x4 v0 = acc[ai][0][m][0], v1 = acc[ai][0][m][1];
                    if (colw < 64) {
                        const int kvr = samp ? MP + ((row - MP) >> 6) * SKV + PAST + ((row - MP) & 63) : row;
                        *(u32x4*)((bf16_t*)(ws + WS_KIX) + (size_t)kvr * 64 + colw) = pack8bf(v0, v1);
                        float* o = out + (samp ? O_SIDX + (size_t)(row - MP) * 64 : O_PIDX + (size_t)row * 64) + colw;
                        *(f32x4*)o = v0; *(f32x4*)(o + 4) = v1;
                    } else { float* o = (float*)(ws + WS_WIX) + (size_t)row * 16 + (colw - 64); *(f32x4*)o = v0; *(f32x4*)(o + 4) = v1; } }
            return;
        }
        const int seg = pn >> 2, cseg = (pn & 3) * 256 + colw;
        if (seg == 0 || seg == 3 || seg == 6) {
            bf16_t* Q = (bf16_t*)(ws + WS_QSB + (size_t)(seg / 3) * (68 * MiB)) + cseg;
#pragma unroll
            for (int ai = 0; ai < 2; ++ai)
#pragma unroll
                for (int m = 0; m < 4; ++m) { bf16_t* rowp = Q + (size_t)(row0 + ai * HALF + m * 16) * 1024;
#pragma unroll
                    for (int bj = 0; bj < 2; ++bj) { const u32x4 w8 = pack8bf(acc[ai][bj][m][0], acc[ai][bj][m][1]); if (seg == 3) __builtin_nontemporal_store(w8, (u32x4*)(rowp + bj * HALF)); else *(u32x4*)(rowp + bj * HALF) = w8; } }
            return;
        }
        const int j = seg < 3 ? seg - 1 : seg - 2;
        bf16_t* KV = (bf16_t*)(ws + WS_KSB + (size_t)j * (196 * MiB)) + cseg;
        float* OF = out + (samp ? O_SSBK + (size_t)j * 2097152 : O_PSBK + (size_t)j * 33554432) + cseg;
#pragma unroll
        for (int ai = 0; ai < 2; ++ai)
#pragma unroll
            for (int m = 0; m < 4; ++m) { const int row = row0 + ai * HALF + m * 16;
                const int kvr = samp ? MP + ((row - MP) >> 6) * SKV + PAST + ((row - MP) & 63) : row;
                bf16_t* rowb = KV + (size_t)kvr * 1024; float* rowf = OF + (size_t)(samp ? row - MP : row) * 1024;
#pragma unroll
                for (int bj = 0; bj < 2; ++bj) { const f32x4 v0 = acc[ai][bj][m][0], v1 = acc[ai][bj][m][1];
                    if (j >= 2) __builtin_nontemporal_store(pack8bf(v0, v1), (u32x4*)(rowb + bj * HALF)); else *(u32x4*)(rowb + bj * HALF) = pack8bf(v0, v1); __builtin_nontemporal_store(v0, (f32x4*)(rowf + bj * HALF)); __builtin_nontemporal_store(v1, (f32x4*)(rowf + bj * HALF + 4)); } }
    }
};
struct EpiBr1 {
    static constexpr bool PERM = true, AFTER_DRAIN = false;
    unsigned char* ws;
    __device__ __forceinline__ void operator()(const f32x4 (&acc)[2][2][4][2], const Unit& u, int wr, int wc, int fr, int fq) const {
        const int col0 = u.pn * BM + wc * 32 + 8 * fq, row0 = u.pm * BM + wr * 64 + fr;
#pragma unroll
        for (int ai = 0; ai < 2; ++ai)
#pragma unroll
            for (int m = 0; m < 4; ++m) { const size_t row = (size_t)(row0 + ai * HALF + m * 16);
                const bf16_t* g = (const bf16_t*)(ws + WS_G) + row * 4096 + col0; bf16_t* t = (bf16_t*)(ws + WS_TMP) + row * 2048 + col0;
#pragma unroll
                for (int bj = 0; bj < 2; ++bj) { f32x4 g0, g1; unpack8bf(*(const u32x4*)(g + bj * HALF), g0, g1);
                    *(u32x4*)(t + bj * HALF) = pack8bf(acc[ai][bj][m][0] * g0, acc[ai][bj][m][1] * g1); } }
    }
};
struct EpiBr2 {
    static constexpr bool PERM = true, AFTER_DRAIN = false;
    unsigned char* ws;
    __device__ __forceinline__ void operator()(const f32x4 (&acc)[2][2][4][2], const Unit& u, int wr, int wc, int fr, int fq) const {
        const int col0 = u.pn * BM + wc * 32 + 8 * fq, row0 = u.pm * BM + wr * 64 + fr;
#pragma unroll
        for (int ai = 0; ai < 2; ++ai)
#pragma unroll
            for (int m = 0; m < 4; ++m) { const size_t row = (size_t)(row0 + ai * HALF + m * 16);
                const bf16_t* g = (const bf16_t*)(ws + WS_G) + row * 4096 + 2048 + col0; const bf16_t* t = (const bf16_t*)(ws + WS_TMP) + row * 2048 + col0;
                bf16_t* o = (bf16_t*)(ws + WS_MRG) + row * 2048 + col0;
#pragma unroll
                for (int bj = 0; bj < 2; ++bj) { f32x4 g0, g1, t0, t1; unpack8bf(*(const u32x4*)(g + bj * HALF), g0, g1); unpack8bf(*(const u32x4*)(t + bj * HALF), t0, t1);
                    const f32x4 v0 = t0 + acc[ai][bj][m][0] * g0, v1 = t1 + acc[ai][bj][m][1] * g1;
                    *(u32x4*)(o + bj * HALF) = pack8bf(v0, v1); } }
    }
};
struct EpiRes {
    static constexpr bool PERM = true, AFTER_DRAIN = false;
    const float* base_p; const float* base_s; float* dst; const float* mod; int gchunk;
    __device__ __forceinline__ void operator()(const f32x4 (&acc)[2][2][4][2], const Unit& u, int wr, int wc, int fr, int fq) const {
        const int col0 = u.pn * BM + wc * 32 + 8 * fq, row0 = u.pm * BM + wr * 64 + fr;
#pragma unroll
        for (int ai = 0; ai < 2; ++ai) {
            const int rowa = row0 + ai * HALF;
            const float* gt = mod + (size_t)(rowa < MP ? (rowa >> 14) : 2 + ((rowa - MP) >> 6)) * 12288 + gchunk * 2048 + col0;
            const f32x4 g00 = *(const f32x4*)(gt), g01 = *(const f32x4*)(gt + 4), g10 = *(const f32x4*)(gt + HALF), g11 = *(const f32x4*)(gt + HALF + 4);
#pragma unroll
            for (int m = 0; m < 4; ++m) { const int row = rowa + m * 16;
                const float* b = (row < MP ? base_p + (size_t)row * 2048 : base_s + (size_t)(row - MP) * 2048) + col0;
                float* o = dst + (size_t)row * 2048 + col0;
                *(f32x4*)(o) = *(const f32x4*)(b) + g00 * acc[ai][0][m][0];
                *(f32x4*)(o + 4) = *(const f32x4*)(b + 4) + g01 * acc[ai][0][m][1];
                *(f32x4*)(o + HALF) = *(const f32x4*)(b + HALF) + g10 * acc[ai][1][m][0];
                *(f32x4*)(o + HALF + 4) = *(const f32x4*)(b + HALF + 4) + g11 * acc[ai][1][m][1]; } }
    }
};
#define PG8_DPP_ROR(x, n) __builtin_bit_cast(float, __builtin_amdgcn_update_dpp(0, __builtin_bit_cast(int, (x)), 0x120 + (n), 0xf, 0xf, false))
struct EpiUpConv {
    static constexpr bool PERM = true, AFTER_DRAIN = false;
    unsigned char* ws; float* out; const float* cw; const float* cb; const float* st; PG8_LAS float* halo;
    __device__ __forceinline__ void operator()(const f32x4 (&acc)[2][2][4][2], const Unit& u, int wr, int wc, int fr, int fq) const {
        const int pn = u.pn, pm = u.pm; const bool samp = pm >= 128;
        const int colw = wc * 32 + 8 * fq, ch0 = pn * 128 + colw, row0 = pm * BM + wr * 64 + fr;
        if (fr >= 14) {
#pragma unroll
            for (int ai = 0; ai < 2; ++ai) { PG8_LAS float* h = halo + ((ai * 2 + wr) * 2 + (fr - 14)) * 128 + colw;
                *(PG8_LAS f32x4*)h = acc[ai][0][3][0]; *(PG8_LAS f32x4*)(h + 4) = acc[ai][0][3][1]; } }
        asm volatile("s_waitcnt lgkmcnt(0)" ::: "memory"); __builtin_amdgcn_s_barrier(); asm volatile("" ::: "memory");
        float w0[8], w1[8], w2[8], bb[8];
#pragma unroll
        for (int j = 0; j < 8; ++j) { w0[j] = cw[ch0 + j]; w1[j] = cw[DFF + ch0 + j]; w2[j] = cw[2 * DFF + ch0 + j]; bb[j] = cb[ch0 + j]; }
#pragma unroll
        for (int ai = 0; ai < 2; ++ai) {
            float e1[8], e2[8];
            const int grow0 = pm * BM + ai * HALF + wr * 64;
            bool defer = false;
            if (samp) { const float* s0 = st + (size_t)((grow0 - MP) >> 6) * 2 * DFF + ch0;
#pragma unroll
                for (int j = 0; j < 8; ++j) { e2[j] = s0[j]; e1[j] = s0[DFF + j]; } }
            else if (ai == 0 && wr == 0) { defer = (pm & 63) != 0;
#pragma unroll
                for (int j = 0; j < 8; ++j) { e2[j] = 0.f; e1[j] = 0.f; } }
            else { const int pg = ai * 2 + wr - 1; const PG8_LAS float* h = halo + (pg * 2) * 128 + colw;
                const f32x4 a0 = *(const PG8_LAS f32x4*)h, a1 = *(const PG8_LAS f32x4*)(h + 4), b0 = *(const PG8_LAS f32x4*)(h + 128), b1 = *(const PG8_LAS f32x4*)(h + 132);
#pragma unroll
                for (int j = 0; j < 4; ++j) { e2[j] = a0[j]; e2[4 + j] = a1[j]; e1[j] = b0[j]; e1[4 + j] = b1[j]; } }
            float pr1[8], pr2[8];
#pragma unroll
            for (int j = 0; j < 8; ++j) { pr1[j] = e1[j]; pr2[j] = fr == 0 ? e2[j] : e1[j]; }
#pragma unroll
            for (int m = 0; m < 4; ++m) { const int row = row0 + ai * HALF + m * 16;
                float g[8], v[8], o[8];
#pragma unroll
                for (int j = 0; j < 4; ++j) { g[j] = acc[ai][0][m][0][j]; g[4 + j] = acc[ai][0][m][1][j]; v[j] = acc[ai][1][m][0][j]; v[4 + j] = acc[ai][1][m][1][j]; }
#pragma unroll
                for (int j = 0; j < 8; ++j) { const float r1 = PG8_DPP_ROR(g[j], 1), r2 = PG8_DPP_ROR(g[j], 2);
                    const float p1 = fr == 0 ? pr1[j] : r1;
                    const float p2 = fr <= 1 ? pr2[j] : r2;
                    const float cv = bb[j] + w0[j] * p2 + w1[j] * p1 + w2[j] * g[j];
                    o[j] = cv * sigm(cv) * v[j];
                    pr1[j] = r1; pr2[j] = r2; }
                if (!(defer && m == 0 && fr < 2)) { bf16_t* op = (bf16_t*)(ws + WS_ACT) + (size_t)row * DFF + ch0; __builtin_nontemporal_store(pack8bf((f32x4){o[0], o[1], o[2], o[3]}, (f32x4){o[4], o[5], o[6], o[7]}), (u32x4*)op); }
                if (m == 0 && fr < 2 && defer) { float* hp = (float*)(ws + WS_HEAD) + (((size_t)pm * 44 + pn) * 4 + fr) * 128 + colw;
#pragma unroll
                    for (int j = 0; j < 8; ++j) { hp[j] = g[j]; hp[256 + j] = v[j]; } }
                if (m == 3 && fr >= 14) {
                    if (!samp && ai == 1 && wr == 1) { float* tp = (float*)(ws + WS_TAIL) + (((size_t)pm * 44 + pn) * 2 + (fr - 14)) * 128 + colw;
#pragma unroll
                        for (int j = 0; j < 8; ++j) tp[j] = g[j]; }
                    float* so = nullptr;
                    if (!samp) { if (ai == 1 && wr == 1 && (pm & 63) == 63) so = out + O_PCONV + (size_t)((pm >> 6) * 2 + (fr - 14)) * DFF; }
                    else so = out + O_SCONV + (size_t)(((row - MP) >> 6) * 2 + (fr - 14)) * DFF;
                    if (so) {
#pragma unroll
                        for (int j = 0; j < 8; ++j) so[ch0 + j] = g[j]; } } }
        }
        asm volatile("s_waitcnt lgkmcnt(0)" ::: "memory"); __builtin_amdgcn_s_barrier(); asm volatile("" ::: "memory");
    }
};
template <class Epi, class Sched, bool ALIGN_EPI = false, bool SP2 = false>
__device__ __forceinline__ void gemm_phase(PG8_LAS unsigned char* lds, const Gemm g, const Sched& S, const Epi& E) {
    const int tid = threadIdx.x, wid = __builtin_amdgcn_readfirstlane(tid >> 6), lane = tid & 63, wr = wid >> 2, wc = wid & 3, fr = lane & 15, fq = lane >> 4;
    const int K = g.K, nt = K / BK;
    unsigned voffA[2], voffB[2];
#pragma unroll
    for (int i = 0; i < 2; ++i) { int R, C; stage_rc(tid * 16 + i * 8192, R, C); const int Rb = Epi::PERM ? ((R & ~31) + perm32(R & 31)) : R;
        voffA[i] = (unsigned)(R * K + C) * 2u; voffB[i] = (unsigned)(Rb * K + C) * 2u; }
    const size_t kstep = (size_t)(BK * 2);
    const size_t hstep = (size_t)HALF * K * 2;
    const size_t tstep = 2 * hstep;
    const unsigned ldsw = (unsigned)wid * 1024u;
    const int aoff = lds_byte(wr * 64 + fr, fq * 8), boff = lds_byte(wc * 32 + fr, fq * 8);
#define PG8_SA(b, h) (((b) * 2 + (h)) * HTB)
#define PG8_SB(b, h) ((4 + (b) * 2 + (h)) * HTB)
#define PG8_STAGE(bufoff, gbase, voff) do { _Pragma("unroll") for (int _i = 0; _i < 2; ++_i) \
        __builtin_amdgcn_global_load_lds((const unsigned*)((const char*)(gbase) + (voff)[_i]), (PG8_LAS unsigned*)(lds + (bufoff) + ldsw + _i * 8192), 16, 0, 0); } while (0)
#define PG8_LDA(dst, b, h) do { _Pragma("unroll") for (int m = 0; m < 4; ++m) _Pragma("unroll") for (int k = 0; k < 2; ++k) dst[m][k] = *(const PG8_LAS bf16x8*)(lds + PG8_SA(b, h) + aoff + m * 2048 + k * 1024); } while (0)
#define PG8_LDB(dst, b, h) do { _Pragma("unroll") for (int n = 0; n < 2; ++n) _Pragma("unroll") for (int k = 0; k < 2; ++k) dst[n][k] = *(const PG8_LAS bf16x8*)(lds + PG8_SB(b, h) + boff + n * 2048 + k * 1024); } while (0)
#define PG8_MMA(ai, bj, At, Bt) do { __builtin_amdgcn_s_setprio(1); _Pragma("unroll") for (int m = 0; m < 4; ++m) _Pragma("unroll") for (int n = 0; n < 2; ++n) _Pragma("unroll") for (int k = 0; k < 2; ++k) \
        acc[ai][bj][m][n] = __builtin_amdgcn_mfma_f32_16x16x32_bf16(Bt[n][k], At[m][k], acc[ai][bj][m][n], 0, 0, 0); __builtin_amdgcn_s_setprio(0); } while (0)
#define PG8_WAIT_V(n) asm volatile("s_waitcnt vmcnt(" #n ")" ::: "memory")
#define PG8_WAIT_L(n) asm volatile("s_waitcnt lgkmcnt(" #n ")" ::: "memory")
#define PG8_BAR __builtin_amdgcn_s_barrier()
#define PG8_SCHED __builtin_amdgcn_sched_barrier(0)
    Unit cur, nxt; int ui = 0;
    if (!S.next(0, cur)) return;
    f32x4 acc[2][2][4][2];
#pragma unroll
    for (int a = 0; a < 2; ++a)
#pragma unroll
        for (int b = 0; b < 2; ++b)
#pragma unroll
            for (int m = 0; m < 4; ++m)
#pragma unroll
                for (int n = 0; n < 2; ++n) acc[a][b][m][n] = (f32x4){0.f, 0.f, 0.f, 0.f};
    bf16x8 At[4][2], B0[2][2], B1[2][2];
    const char* cA = (const char*)g.A + (size_t)cur.pm * tstep; const char* cB = (const char*)g.Bt + (size_t)cur.pn * tstep;
    S.a_ready(cur);
    if constexpr (SP2) {
        PG8_STAGE(PG8_SB(0, 0), cB, voffB); PG8_STAGE(PG8_SB(0, 1), cB + hstep, voffB); PG8_STAGE(PG8_SA(0, 0), cA, voffA); PG8_STAGE(PG8_SA(0, 1), cA + hstep, voffA);
        if (wr == 1) PG8_BAR;
        PG8_WAIT_V(2); PG8_BAR;
        PG8_STAGE(PG8_SB(1, 0), cB + kstep, voffB); PG8_STAGE(PG8_SA(1, 0), cA + kstep, voffA); PG8_STAGE(PG8_SB(1, 1), cB + hstep + kstep, voffB);
        PG8_WAIT_V(6); PG8_BAR;
    } else {
        PG8_STAGE(PG8_SB(0, 0), cB, voffB); PG8_STAGE(PG8_SA(0, 0), cA, voffA); PG8_STAGE(PG8_SB(0, 1), cB + hstep, voffB); PG8_STAGE(PG8_SA(0, 1), cA + hstep, voffA);
        if (wr == 1) PG8_BAR;
        PG8_WAIT_V(4); PG8_BAR;
        PG8_STAGE(PG8_SB(1, 0), cB + kstep, voffB); PG8_STAGE(PG8_SA(1, 0), cA + kstep, voffA); PG8_STAGE(PG8_SB(1, 1), cB + hstep + kstep, voffB);
        PG8_WAIT_V(6); PG8_BAR;
    }
    for (;;) {
        const bool has_next = S.next(ui + 1, nxt);
        const char* nA = has_next ? (const char*)g.A + (size_t)nxt.pm * tstep : cA; const char* nB = has_next ? (const char*)g.Bt + (size_t)nxt.pn * tstep : cB;
        for (int t = 0; t < nt; t += 2) {
            const bool last = (t == nt - 2);
            const char* a1 = cA + (size_t)(t + 1) * kstep;
            const char* a2 = last ? nA : cA + (size_t)(t + 2) * kstep; const char* b2 = last ? nB : cB + (size_t)(t + 2) * kstep;
            const char* a3 = a2 + kstep; const char* b3 = b2 + kstep;
            if (last && has_next) S.a_ready(nxt);
            if constexpr (SP2) {
            PG8_LDB(B0, 0, 0); PG8_LDB(B1, 0, 1); PG8_SCHED; PG8_LDA(At, 0, 0); PG8_STAGE(PG8_SA(1, 1), a1 + hstep, voffA);
            PG8_WAIT_V(8); PG8_WAIT_L(0); PG8_BAR; PG8_MMA(0, 0, At, B0); PG8_MMA(0, 1, At, B1); PG8_BAR; PG8_SCHED;
            PG8_LDA(At, 0, 1); PG8_STAGE(PG8_SB(0, 0), b2, voffB); PG8_STAGE(PG8_SB(0, 1), b2 + hstep, voffB); PG8_STAGE(PG8_SA(0, 0), a2, voffA);
            PG8_WAIT_V(8); PG8_WAIT_L(0); PG8_BAR; PG8_MMA(1, 0, At, B0); PG8_MMA(1, 1, At, B1); PG8_BAR; PG8_SCHED;
            PG8_LDB(B0, 1, 0); PG8_LDB(B1, 1, 1); PG8_SCHED; PG8_LDA(At, 1, 0); PG8_STAGE(PG8_SA(0, 1), a2 + hstep, voffA);
            PG8_WAIT_V(8); PG8_WAIT_L(0); PG8_BAR; PG8_MMA(0, 0, At, B0); PG8_MMA(0, 1, At, B1); PG8_BAR; PG8_SCHED;
            PG8_LDA(At, 1, 1); PG8_STAGE(PG8_SB(1, 0), b3, voffB); PG8_STAGE(PG8_SB(1, 1), b3 + hstep, voffB); PG8_STAGE(PG8_SA(1, 0), a3, voffA);
            PG8_WAIT_V(8); PG8_WAIT_L(0); PG8_BAR; PG8_MMA(1, 0, At, B0); PG8_MMA(1, 1, At, B1); PG8_BAR; PG8_SCHED;
            } else {
            PG8_LDB(B0, 0, 0); PG8_SCHED; PG8_LDA(At, 0, 0); PG8_STAGE(PG8_SA(1, 1), a1 + hstep, voffA);
            PG8_WAIT_L(8); PG8_BAR; PG8_WAIT_L(0); PG8_MMA(0, 0, At, B0); PG8_BAR; PG8_SCHED;
            PG8_LDB(B1, 0, 1); PG8_STAGE(PG8_SB(0, 0), b2, voffB);
            PG8_BAR; PG8_WAIT_L(0); PG8_MMA(0, 1, At, B1); PG8_BAR;
            PG8_LDA(At, 0, 1); PG8_STAGE(PG8_SA(0, 0), a2, voffA);
            PG8_BAR; PG8_WAIT_L(0); PG8_MMA(1, 0, At, B0); PG8_BAR; PG8_SCHED;
            PG8_STAGE(PG8_SB(0, 1), b2 + hstep, voffB);
            PG8_WAIT_V(6); PG8_BAR; PG8_MMA(1, 1, At, B1); PG8_BAR;
            PG8_LDB(B0, 1, 0); PG8_SCHED; PG8_LDA(At, 1, 0); PG8_STAGE(PG8_SA(0, 1), a2 + hstep, voffA);
            PG8_WAIT_L(8); PG8_BAR; PG8_WAIT_L(0); PG8_MMA(0, 0, At, B0); PG8_BAR; PG8_SCHED;
            PG8_LDB(B1, 1, 1); PG8_STAGE(PG8_SB(1, 0), b3, voffB);
            PG8_BAR; PG8_WAIT_L(0); PG8_MMA(0, 1, At, B1); PG8_BAR;
            PG8_LDA(At, 1, 1); PG8_STAGE(PG8_SA(1, 0), a3, voffA);
            PG8_BAR; PG8_WAIT_L(0); PG8_MMA(1, 0, At, B0); PG8_BAR; PG8_SCHED;
            PG8_STAGE(PG8_SB(1, 1), b3 + hstep, voffB);
            PG8_WAIT_V(6); PG8_BAR; PG8_MMA(1, 1, At, B1); PG8_BAR;
            }
        }
        if constexpr (ALIGN_EPI) { if (wr == 0) PG8_BAR; }
        if constexpr (!Epi::AFTER_DRAIN) { E(acc, cur, wr, wc, fr, fq); S.done(cur); }
        if (!has_next) break;
#pragma unroll
        for (int a = 0; a < 2; ++a)
#pragma unroll
            for (int b = 0; b < 2; ++b)
#pragma unroll
                for (int m = 0; m < 4; ++m)
#pragma unroll
                    for (int n = 0; n < 2; ++n) acc[a][b][m][n] = (f32x4){0.f, 0.f, 0.f, 0.f};
        cur = nxt; cA = nA; cB = nB; ++ui;
        if constexpr (ALIGN_EPI) { if (wr == 1) PG8_BAR; }
    }
    PG8_WAIT_V(0);
    if constexpr (!ALIGN_EPI) { if (wr == 0) PG8_BAR; }
    PG8_BAR;
    if constexpr (Epi::AFTER_DRAIN) { E.fused(acc, cur, wr, wc, fr, fq, lds, wid, lane); S.done(cur); }
#undef PG8_SA
#undef PG8_SB
#undef PG8_STAGE
#undef PG8_LDA
#undef PG8_LDB
#undef PG8_MMA
#undef PG8_WAIT_V
#undef PG8_WAIT_L
#undef PG8_BAR
#undef PG8_SCHED
}
}
#define XB_TMO      128
#define XB_XCNT(j)  (256  + 64 * (j))
#define XB_XSUB(j)  (1280 + 64 * (j))
#define XB_XGEN(j)  (2304 + 64 * (j))
#define XB_TOP      3328
#define XB_TOPGEN   3392
#define XCD_BAR_WORDS 3456
#define XB_SPIN_CAP (1u << 18)
#define LAS __attribute__((address_space(3)))

__device__ __forceinline__ unsigned xb_ld(unsigned* p)              { return __hip_atomic_load(p, __ATOMIC_RELAXED, __HIP_MEMORY_SCOPE_AGENT); }
__device__ __forceinline__ unsigned xb_add(unsigned* p, unsigned v) { return __hip_atomic_fetch_add(p, v, __ATOMIC_RELAXED, __HIP_MEMORY_SCOPE_AGENT); }
__device__ __forceinline__ unsigned xb_xcc_id() { return (unsigned)__builtin_amdgcn_s_getreg((3 << 11) | 20) & 0xFu; }
#define XB_SPIN(cond, bar) do { unsigned _sp = 0; while (cond) { __builtin_amdgcn_s_sleep(1); \
    if ((++_sp & 255u) == 0u) { if (xb_ld(&(bar)[XB_TMO])) break; if (_sp > XB_SPIN_CAP) { atomicAdd(&(bar)[XB_TMO], 1u); break; } } } } while (0)

struct XcdBarrier {
    unsigned* bar; unsigned x;
    volatile LAS unsigned* st;
};

__device__ __forceinline__ XcdBarrier xcd_barrier_post(unsigned* bar, volatile LAS unsigned* st) {
    XcdBarrier b; b.bar = bar; b.x = xb_xcc_id(); b.st = st;
    if (threadIdx.x == 0) (void)xb_add(&bar[XB_XCNT(b.x)], 1u);
    return b;
}
__device__ __forceinline__ void xcd_barrier_complete(unsigned* bar, unsigned x, unsigned& nloc, unsigned& nx) {
    const unsigned G = gridDim.x * gridDim.y * gridDim.z;
    unsigned sum, cnt, mine, sp = 0u;
    for (;;) {
        sum = 0u; cnt = 0u; mine = 0u;
#pragma unroll
        for (unsigned j = 0; j < 16; ++j) { const unsigned c = xb_ld(&bar[XB_XCNT(j)]); sum += c; cnt += (c > 0u) ? 1u : 0u; mine = (j == x) ? c : mine; }
        if (sum == G) break;
        __builtin_amdgcn_s_sleep(1);
        if ((++sp & 255u) == 0u) { if (xb_ld(&bar[XB_TMO])) break; if (sp > XB_SPIN_CAP) { atomicAdd(&bar[XB_TMO], 1u); break; } }
    }
    nloc = mine > 0u ? mine : 1u; nx = cnt > 0u ? cnt : 1u;
}

__device__ __forceinline__ void xcd_barrier(const XcdBarrier& b) {
    asm volatile("s_waitcnt vmcnt(0)" ::: "memory");
    __syncthreads();
    if (threadIdx.x == 0) {
        unsigned* bar = b.bar;
        __builtin_amdgcn_s_waitcnt(0);
        unsigned nloc = b.st[0], nx = b.st[1];
        if (nloc == 0u) { xcd_barrier_complete(bar, b.x, nloc, nx); b.st[0] = nloc; b.st[1] = nx; }
        const unsigned old = xb_add(&bar[XB_XSUB(b.x)], 1u);
        const unsigned gen = old / nloc;
        if (old + 1u == (gen + 1u) * nloc) {
            __builtin_amdgcn_fence(__ATOMIC_RELEASE, "agent");
            asm volatile("s_waitcnt vmcnt(0)" ::: "memory");
            const unsigned og = xb_add(&bar[XB_TOP], 1u);
            const unsigned tg = og / nx;
            if (og + 1u == (tg + 1u) * nx) xb_add(&bar[XB_TOPGEN], 1u);
            else XB_SPIN(xb_ld(&bar[XB_TOPGEN]) == tg, bar);
            __builtin_amdgcn_fence(__ATOMIC_ACQUIRE, "agent");
            xb_add(&bar[XB_XGEN(b.x)], 1u);
            asm volatile("s_waitcnt vmcnt(0)" ::: "memory");
        } else {
            XB_SPIN(xb_ld(&bar[XB_XGEN(b.x)]) == gen, bar);
            __builtin_amdgcn_fence(__ATOMIC_ACQUIRE, "agent");
            asm volatile("s_waitcnt vmcnt(0)" ::: "memory");
        }
    }
    __syncthreads();
}
__device__ __forceinline__ void xcd_count_in(const XcdBarrier& b, unsigned* loc, unsigned* glob) {
    const unsigned nloc = b.st[0];
    const unsigned old = xb_add(loc + 64 * b.x, 1u);
    if (old + 1u == nloc) { __builtin_amdgcn_fence(__ATOMIC_RELEASE, "agent"); asm volatile("s_waitcnt vmcnt(0)" ::: "memory"); (void)xb_add(glob, nloc); }
}
constexpr int NWAVES = 8;
struct Frame {
    LAS unsigned char* lds;
    unsigned char* ws; float* out;
    int tid, lane, wave, G, c;
    const float* in[25];
};
enum { I_XP = 0, I_XS, I_CSBK, I_CSBV, I_CSAK, I_CSAV, I_CIDX, I_CONVST, I_CP, I_CS, I_WADA, I_BADA, I_GMIX, I_WIN, I_WGATE, I_WBRSB, I_WBRSA, I_WOUT, I_REL, I_GFFN, I_WUP, I_CONVW, I_CONVB, I_WDOWN, I_GFINAL };

__device__ __forceinline__ void p0_transpose_item(const float* W, int K, int N, bf16* WT, int row_off, LAS float* scr, int item, int lane) {
    const int nblk = (N + 31) / 32, kb = item / nblk, nb = item % nblk, k0 = 64 * kb, n0 = 32 * nb;
    const int cg = 4 * (lane & 7); const bool cok = (n0 + cg) < N;
    f32x4 tv[8];
#pragma unroll
    for (int i = 0; i < 8; ++i) { const int kk = 8 * i + (lane >> 3); tv[i] = cok ? *(const GAS f32x4*)(W + (size_t)(k0 + kk) * N + n0 + cg) : (f32x4){0.f, 0.f, 0.f, 0.f}; }
#pragma unroll
    for (int i = 0; i < 8; ++i) { LAS float* d = scr + (8 * i + (lane >> 3)) * 33 + cg; d[0] = tv[i][0]; d[1] = tv[i][1]; d[2] = tv[i][2]; d[3] = tv[i][3]; }
    LDS_WAIT(); asm volatile("" ::: "memory");
    const int c = lane & 7;
#pragma unroll
    for (int j = 0; j < 4; ++j) { const int n = (lane >> 3) + 8 * j; const LAS float* s = scr + (8 * c) * 33 + n;
        v4u o; o.x = pk2(s[0 * 33], s[1 * 33]); o.y = pk2(s[2 * 33], s[3 * 33]); o.z = pk2(s[4 * 33], s[5 * 33]); o.w = pk2(s[6 * 33], s[7 * 33]);
        if (n0 + n < N) *(GAS v4u*)(WT + (size_t)(row_off + n0 + n) * K + k0 + 8 * c) = o; }
    LDS_WAIT(); asm volatile("" ::: "memory");
}
__device__ __forceinline__ void p0_mod(Frame& F, int blk) {
    const float* wada = F.in[I_WADA]; const int l15 = F.lane & 15, l4 = F.lane >> 4;
    f32x4 acc[3][4];
#pragma unroll
    for (int rb = 0; rb < 3; ++rb)
#pragma unroll
        for (int cb = 0; cb < 4; ++cb) acc[rb][cb] = (f32x4){0.f, 0.f, 0.f, 0.f};
    const int kw = F.wave * 256 + l4;
    const float* a0 = F.in[I_CP] + (size_t)(l15 < 2 ? l15 : 0) * DM + kw;
    const float* a0s = F.in[I_CS] + (size_t)(l15 < 2 ? 0 : l15 - 2) * DM + kw;
    const float* a1 = F.in[I_CS] + (size_t)(14 + l15) * DM + kw;
    const float* a2 = F.in[I_CS] + (size_t)(l15 < 2 ? 30 + l15 : 30) * DM + kw;
    const float* bp = wada + (size_t)kw * 12288 + blk * 64 + l15;
#pragma unroll 4
    for (int ks = 0; ks < 64; ++ks) {
        const float c0 = l15 < 2 ? a0[4 * ks] : a0s[4 * ks], c1 = a1[4 * ks], c2 = l15 < 2 ? a2[4 * ks] : 0.f;
        const float s0 = c0 * sigmoidf_(c0), s1 = c1 * sigmoidf_(c1), s2 = c2 * sigmoidf_(c2);
        float bv[4];
#pragma unroll
        for (int cb = 0; cb < 4; ++cb) bv[cb] = bp[(size_t)(4 * ks) * 12288 + 16 * cb];
#pragma unroll
        for (int cb = 0; cb < 4; ++cb) { acc[0][cb] = __builtin_amdgcn_mfma_f32_16x16x4f32(s0, bv[cb], acc[0][cb], 0, 0, 0);
                                         acc[1][cb] = __builtin_amdgcn_mfma_f32_16x16x4f32(s1, bv[cb], acc[1][cb], 0, 0, 0);
                                         acc[2][cb] = __builtin_amdgcn_mfma_f32_16x16x4f32(s2, bv[cb], acc[2][cb], 0, 0, 0); }
    }
    LAS float* red = (LAS float*)(F.lds + RING_OFF);
#pragma unroll
    for (int rb = 0; rb < 3; ++rb)
#pragma unroll
        for (int cb = 0; cb < 4; ++cb)
#pragma unroll
            for (int i = 0; i < 4; ++i) { const int row = 16 * rb + 4 * l4 + i; if (row < 34) red[(F.wave * 34 + row) * 64 + 16 * cb + l15] = acc[rb][cb][i]; }
    __syncthreads();
    float* mod = (float*)(F.ws + WS_MOD);
    for (int o = F.tid; o < 34 * 64; o += NWAVES * 64) { const int b = o >> 6, l = o & 63; float v = F.in[I_BADA][blk * 64 + l];
#pragma unroll
        for (int w = 0; w < 8; ++w) v += red[(w * 34 + b) * 64 + l];
        mod[(size_t)b * 12288 + blk * 64 + l] = v; }
    __syncthreads();
}
__device__ __forceinline__ void p0_prologue(Frame& F) {
    if (F.c < 192) p0_mod(F, F.c);
    LAS float* scr = (LAS float*)(F.lds + RING_OFF + F.wave * 16384);
    const int gw = F.c * NWAVES + F.wave, NGW = F.G * NWAVES;
    constexpr int I0 = 32 * 227, I1 = 32 * 128, I2 = 16 * 64, I3 = 16 * 64, I4 = 32 * 64, I5 = 32 * 352, I6 = 88 * 64;
    constexpr int NITEMS = I0 + I1 + I2 + I3 + I4 + I5 + I6;
    for (int it = gw; it < NITEMS; it += NGW) {
        int r = it;
        if (r < I0) { p0_transpose_item(F.in[I_WIN], 2048, 7248, (bf16*)(F.ws + WS_WCAT), 0, scr, r, F.lane); continue; } r -= I0;
        if (r < I1) { p0_transpose_item(F.in[I_WGATE], 2048, 4096, (bf16*)(F.ws + WS_WCAT), NGATE0, scr, r, F.lane); continue; } r -= I1;
        if (r < I2) { p0_transpose_item(F.in[I_WBRSB], 1024, 2048, (bf16*)(F.ws + WS_WBRSB), 0, scr, r, F.lane); continue; } r -= I2;
        if (r < I3) { p0_transpose_item(F.in[I_WBRSA], 1024, 2048, (bf16*)(F.ws + WS_WBRSA), 0, scr, r, F.lane); continue; } r -= I3;
        if (r < I4) { p0_transpose_item(F.in[I_WOUT], 2048, 2048, (bf16*)(F.ws + WS_WOUT), 0, scr, r, F.lane); continue; } r -= I4;
        if (r < I5) { const int n0 = 32 * (r % 352), bj = n0 / DFF, ch = n0 % DFF;
            p0_transpose_item(F.in[I_WUP], 2048, NUP, (bf16*)(F.ws + WS_WUP), 256 * (ch >> 7) + 128 * bj + (ch & 127) - n0, scr, r, F.lane); continue; } r -= I5;
        p0_transpose_item(F.in[I_WDOWN], DFF, 2048, (bf16*)(F.ws + WS_WDOWN), 0, scr, r, F.lane);
    }
    const size_t gt = (size_t)F.c * (NWAVES * 64) + F.tid, NGT = (size_t)F.G * NWAVES * 64;
    for (size_t i = gt; i < 45056; i += NGT) *(GAS v4u*)((bf16*)(F.ws + WS_WCAT) + (size_t)7248 * 2048 + i * 8) = (v4u){0u, 0u, 0u, 0u};
    { const float* src = F.in[I_CIDX]; bf16* dst = (bf16*)(F.ws + WS_KIX);
        for (size_t i = gt; i < (size_t)524288; i += NGT) { const size_t e = i * 8, s = e >> 17, rem = e & 131071;
            const f32x4 a = *(const GAS f32x4*)(src + e), b = *(const GAS f32x4*)(src + e + 4);
            v4u o; o.x = pk2(a[0], a[1]); o.y = pk2(a[2], a[3]); o.z = pk2(b[0], b[1]); o.w = pk2(b[2], b[3]);
            *(GAS v4u*)(dst + ((size_t)MP + s * SKV) * 64 + rem) = o; } }
}
__device__ __forceinline__ void norm_mod_rows(Frame& F, const float* xp, const float* xs, const float* g, int shchunk, int scchunk, int row0, int row1, int widx, int nw) {
    const int gw = widx * NWAVES + F.wave, NGW = nw * NWAVES; const float* mod = (const float*)(F.ws + WS_MOD);
    f32x4 gj[8], scj[8], shj[8]; int cur = -1;
#pragma unroll
    for (int j = 0; j < 8; ++j) gj[j] = *(const f32x4*)(g + 4 * (F.lane + 64 * j));
    for (int row = row0 + gw; row < row1; row += NGW) {
        const GAS f32x4* xr = (const GAS f32x4*)(row < MP ? xp + (size_t)row * DM : xs + (size_t)(row - MP) * DM) + F.lane;
        f32x4 v[8]; float ss = 0.f;
#pragma unroll
        for (int j = 0; j < 8; ++j) { v[j] = xr[64 * j]; ss += (v[j].x * v[j].x + v[j].y * v[j].y) + (v[j].z * v[j].z + v[j].w * v[j].w); }
        const int mrow = mod_row(row);
        if (mrow != cur) { cur = mrow; const float* mr = mod + (size_t)mrow * 12288;
#pragma unroll
            for (int j = 0; j < 8; ++j) { const int col = 4 * (F.lane + 64 * j); shj[j] = *(const f32x4*)(mr + shchunk * 2048 + col); scj[j] = *(const f32x4*)(mr + scchunk * 2048 + col) + 1.f; } }
        const float rstd = 1.f / sqrtf(wave_sum(ss) * (1.f / DM) + EPS);
        GAS v2u* o8 = (GAS v2u*)((bf16*)(F.ws + WS_HB) + (size_t)row * DM) + F.lane;
#pragma unroll
        for (int j = 0; j < 8; ++j) {
            const f32x4 y = (v[j] * rstd) * gj[j] * scj[j] + shj[j];
            v2u w; w.x = pk2(y[0], y[1]); w.y = pk2(y[2], y[3]); o8[64 * j] = w; }
    }
}
__device__ __forceinline__ void final_norm_rows(Frame& F, int row0, int row1, int widx, int nw) {
    const int gw = widx * NWAVES + F.wave, NGW = nw * NWAVES; const float* g = F.in[I_GFINAL];
    f32x4 gj[8];
#pragma unroll
    for (int j = 0; j < 8; ++j) gj[j] = *(const f32x4*)(g + 4 * (F.lane + 64 * j));
    for (int row = row0 + gw; row < row1; row += NGW) {
        GAS f32x4* xr = (GAS f32x4*)(F.out + O_Y + (size_t)row * DM) + F.lane;
        f32x4 v[8]; float ss = 0.f;
#pragma unroll
        for (int j = 0; j < 8; ++j) { v[j] = xr[64 * j]; ss += (v[j].x * v[j].x + v[j].y * v[j].y) + (v[j].z * v[j].z + v[j].w * v[j].w); }
        const float rstd = 1.f / sqrtf(wave_sum(ss) * (1.f / DM) + EPS);
#pragma unroll
        for (int j = 0; j < 8; ++j) xr[64 * j] = (v[j] * rstd) * gj[j];
    }
}
__device__ __forceinline__ void conv_fix(Frame& F) {
    const size_t gt = (size_t)F.c * (NWAVES * 64) + F.tid, NGT = (size_t)F.G * NWAVES * 64;
    const float* cw = F.in[I_CONVW]; const float* cb = F.in[I_CONVB];
    const float* TAIL = (const float*)(F.ws + WS_TAIL); const float* HEAD = (const float*)(F.ws + WS_HEAD); bf16* A = (bf16*)(F.ws + WS_ACT);
    for (size_t it = gt; it < (size_t)128 * 44 * 128; it += NGT) {
        const int c = (int)(it & 127), pn = (int)((it >> 7) % 44), pm = (int)((it >> 7) / 44);
        if ((pm & 63) == 0) continue;
        const int ch = pn * 128 + c;
        const float* t = TAIL + ((size_t)(pm - 1) * 44 + pn) * 2 * 128 + c; const float* h = HEAD + ((size_t)pm * 44 + pn) * 4 * 128 + c;
        const float t0 = t[0], t1 = t[128], g0 = h[0], g1 = h[128], v0 = h[256], v1 = h[384];
        const float w0 = cw[ch], w1 = cw[DFF + ch], w2 = cw[2 * DFF + ch], b = cb[ch];
        const float c0 = b + w0 * t0 + w1 * t1 + w2 * g0, c1 = b + w0 * t1 + w1 * g0 + w2 * g1;
        A[(size_t)(pm * 256) * DFF + ch] = (bf16)(pk2(c0 * sigmoidf_(c0) * v0, 0.f) & 0xffffu);
        A[(size_t)(pm * 256 + 1) * DFF + ch] = (bf16)(pk2(c1 * sigmoidf_(c1) * v1, 0.f) & 0xffffu);
    }
}
constexpr int AT_K0 = 0, AT_V0 = 32768, AT_FLAGS = 65536, AT_TAB = 65536 + 256;
constexpr int DS_K0 = 0, DS_V0 = 65536, DS_MASK = 131072, DS_TAB = 131072 + 8192, DS_TABN = DS_TAB + 256, DS_TABN_OFF = 653, DS_TABN_N = 720;
#define MFMA32(a, b, c) __builtin_amdgcn_mfma_f32_32x32x16_bf16((a), (b), (c), 0, 0, 0)
struct AttnUnit { int kv_base, q_tok0, q_pos0, nqw, head; const float* ck; const float* cv; };

__device__ __forceinline__ void at_stage(LAS unsigned char* dst, const bf16* src  , int wave, int lane) {
#pragma unroll
    for (int i = 0; i < 2; ++i) { const int piece = i * 8 + wave, row = 4 * piece + (lane >> 4), ch = (lane & 15) ^ (((row & 3) << 2) | ((row >> 2) & 3));
        __builtin_amdgcn_global_load_lds((const unsigned*)((const char*)src + (size_t)row * 2048 + ch * 16), (LAS unsigned*)(dst + piece * 1024), 16, 0, 0); }
}
__device__ __forceinline__ void at_stage_f32(LAS unsigned char* dst, const float* src  , int wave, int lane) {
#pragma unroll
    for (int i = 0; i < 2; ++i) { const int piece = i * 8 + wave, row = 4 * piece + (lane >> 4), ch = (lane & 15) ^ (((row & 3) << 2) | ((row >> 2) & 3));
        const float* g = src + (size_t)row * 1024 + ch * 8; const f32x4 a = *(const GAS f32x4*)g, b = *(const GAS f32x4*)(g + 4);
        v4u o; o.x = pk2(a[0], a[1]); o.y = pk2(a[2], a[3]); o.z = pk2(b[0], b[1]); o.w = pk2(b[2], b[3]);
        *(LAS v4u*)(dst + piece * 1024 + lane * 16) = o; }
}
__device__ __forceinline__ void at_koffs(int lane, int (&ko)[8]) { const int row = lane & 31, hi = lane >> 5, sw = ((row & 3) << 2) | ((row >> 2) & 3);
#pragma unroll
    for (int ks = 0; ks < 8; ++ks) ko[ks] = 256 * row + 16 * ((2 * ks + hi) ^ sw); }
__device__ __forceinline__ void at_voffs(int lane, int (&vo)[4][2]) { const int hi = lane >> 5, q = (lane >> 2) & 3, cl = 2 * ((lane >> 4) & 1) + ((lane & 3) >> 1);
#pragma unroll
    for (int mt = 0; mt < 4; ++mt)
#pragma unroll
        for (int e = 0; e < 2; ++e) { const int row = 4 * hi + q + 8 * e, sw = ((row & 3) << 2) | ((row >> 2) & 3); vo[mt][e] = 256 * row + 16 * ((4 * mt + cl) ^ sw) + 8 * (lane & 1); } }
__device__ __forceinline__ f32x16 at_qk(const LAS unsigned char* kt, const int (&ko)[8], int sub, const bf16x8 (&qf)[8]) {
    f32x16 p;
#pragma unroll
    for (int r = 0; r < 16; ++r) p[r] = 0.f;
#pragma unroll
    for (int ks = 0; ks < 8; ++ks) { const bf16x8 a = *(const LAS bf16x8*)(kt + ko[ks] + sub * 8192); p = MFMA32(a, qf[ks], p); }
    return p;
}
__device__ __forceinline__ void at_pv_w(f32x16 (&o)[4], const LAS unsigned char* vt, const int (&vo)[4][2], int sub, const unsigned (&pw)[8]) {
#pragma unroll
    for (int s = 0; s < 2; ++s) {
        const v4u w = {pw[4 * s], pw[4 * s + 1], pw[4 * s + 2], pw[4 * s + 3]};
        const bf16x8 pb = __builtin_bit_cast(bf16x8, w);
        s16x4 lo[4], hi4[4];
#pragma unroll
        for (int mt = 0; mt < 4; ++mt) { lo[mt] = __builtin_amdgcn_ds_read_tr16_b64_v4i16((LAS s16x4*)(vt + vo[mt][0] + 256 * (16 * s + 32 * sub)));
                                         hi4[mt] = __builtin_amdgcn_ds_read_tr16_b64_v4i16((LAS s16x4*)(vt + vo[mt][1] + 256 * (16 * s + 32 * sub))); }
#pragma unroll
        for (int mt = 0; mt < 4; ++mt) { const bf16x8 va = (bf16x8){lo[mt][0], lo[mt][1], lo[mt][2], lo[mt][3], hi4[mt][0], hi4[mt][1], hi4[mt][2], hi4[mt][3]};
            o[mt] = MFMA32(va, pb, o[mt]); } }
}
__device__ __forceinline__ void at_pv(f32x16 (&o)[4], const LAS unsigned char* vt, const int (&vo)[4][2], int sub, const f32x16& pr) {
    unsigned pw[8];
#pragma unroll
    for (int k = 0; k < 8; ++k) pw[k] = pk2(pr[2 * k], pr[2 * k + 1]);
    at_pv_w(o, vt, vo, sub, pw);
}
__device__ __forceinline__ void at_load_q(bf16x8 (&qf)[8], const bf16* Q, int tok, int head, int lane) {
    int off = tok * 1024 + head * 128 + 8 * (lane >> 5);
    asm volatile("" : "+v"(off));
    const bf16* p = Q + off;
#pragma unroll
    for (int ks = 0; ks < 8; ++ks) qf[ks] = *(const GAS bf16x8*)(p + 16 * ks);
}
__device__ __forceinline__ void at_store_o(const f32x16 (&o)[4], float inv, bf16* O, int tok, int head, int lane) {
    asm volatile("" : "+v"(tok));
    bf16* p = O + (size_t)tok * 1024 + head * 128 + 4 * (lane >> 5);
#pragma unroll
    for (int mt = 0; mt < 4; ++mt)
#pragma unroll
        for (int g = 0; g < 4; ++g) { v2u w; w.x = pk2(o[mt][4 * g] * inv, o[mt][4 * g + 1] * inv); w.y = pk2(o[mt][4 * g + 2] * inv, o[mt][4 * g + 3] * inv);
            *(GAS v2u*)(p + 32 * mt + 8 * g) = w; }
}
__device__ __forceinline__ float xhalf(float v) { return __shfl_xor(v, 32); }

__device__ __forceinline__ void sb_unit(Frame& F, const AttnUnit& U) {
    const bf16* Kb = (const bf16*)(F.ws + WS_KSB) + (size_t)U.kv_base * 1024 + U.head * 128;
    const bf16* Vb = (const bf16*)(F.ws + WS_VSB) + (size_t)U.kv_base * 1024 + U.head * 128;
    bf16* QO = (bf16*)(F.ws + WS_QSB);
    const int lane = F.lane, wave = F.wave, ql = lane & 31, hi = lane >> 5;
    const bool haveq = wave < U.nqw;
    const int tok = U.q_tok0 + 32 * (haveq ? wave : 0) + ql, qpos = U.q_pos0 + 32 * (haveq ? wave : 0) + ql;
    int ko[8], vo[4][2]; at_koffs(lane, ko); at_voffs(lane, vo);
    bf16x8 qf[8]; at_load_q(qf, QO, tok, U.head, lane);
    f32x16 o[4];
#pragma unroll
    for (int mt = 0; mt < 4; ++mt)
#pragma unroll
        for (int r = 0; r < 16; ++r) o[mt][r] = 0.f;
    float carry = 0.f; bool done = !haveq;
    const int T_hi = (U.q_pos0 + 32 * U.nqw - 1) >> 6;
    volatile LAS unsigned* flags = (volatile LAS unsigned*)(F.lds + AT_FLAGS);
#define SB_STAGE(t) do { if (U.ck && 64 * (t) < PAST) { at_stage_f32(F.lds + AT_K0 + ((t) & 1) * 16384, U.ck + (size_t)(t) * 64 * 1024 + U.head * 128, wave, lane); \
                                                          at_stage_f32(F.lds + AT_V0 + ((t) & 1) * 16384, U.cv + (size_t)(t) * 64 * 1024 + U.head * 128, wave, lane); } \
        else { at_stage(F.lds + AT_K0 + ((t) & 1) * 16384, Kb + (size_t)(t) * 64 * 1024, wave, lane); at_stage(F.lds + AT_V0 + ((t) & 1) * 16384, Vb + (size_t)(t) * 64 * 1024, wave, lane); } } while (0)
    SB_STAGE(T_hi);
    VM_WAIT(); __syncthreads();
    const float C2 = 0.08838834764831845f * 1.4426950408889634f;
    for (int T = T_hi; T >= 0; --T) {
        if (T > 0) SB_STAGE(T - 1);
        const int wq_max = U.q_pos0 + 32 * wave + 31;
        if (!done && 64 * T < wq_max) {
            const LAS unsigned char* kt = F.lds + AT_K0 + (T & 1) * 16384; const LAS unsigned char* vt = F.lds + AT_V0 + (T & 1) * 16384;
#pragma unroll
            for (int sub = 1; sub >= 0; --sub) {
                if (64 * T + 32 * sub >= wq_max) continue;
                f32x16 p = at_qk(kt, ko, sub, qf);
                const int kb0 = 64 * T + 32 * sub + 4 * hi;
                float x[16], zl[16];
#pragma unroll
                for (int r = 0; r < 16; ++r) { const int kp = kb0 + (r & 3) + 8 * (r >> 2); const bool ok = kp < qpos;
                    const float z = p[r] * C2; zl[r] = ok ? z : -__builtin_inff();
                    const float sp = fmaxf(z, 0.f) + __builtin_amdgcn_logf(1.f + __builtin_amdgcn_exp2f(-fabsf(z)));
                    x[r] = ok ? -sp : 0.f; }
                float S[4], Tq[4];
#pragma unroll
                for (int g = 0; g < 4; ++g) { S[g] = (x[4 * g] + x[4 * g + 1]) + (x[4 * g + 2] + x[4 * g + 3]); Tq[g] = xhalf(S[g]); }
                float B = 0.f, ga[4];
#pragma unroll
                for (int g = 3; g >= 0; --g) { ga[g] = B + (hi ? 0.f : Tq[g]); B += S[g] + Tq[g]; }
#pragma unroll
                for (int g = 0; g < 4; ++g) { float run = ga[g] + carry;
#pragma unroll
                    for (int i = 3; i >= 0; --i) { const int r = 4 * g + i; const float aft = run; run += x[r];
                        p[r] = __builtin_amdgcn_exp2f(zl[r] + x[r] + aft); } }
                carry += B;
                at_pv(o, vt, vo, sub, p);
            }
            done = __all(carry < -150.f);
        }
        if (lane == 0) flags[(T & 1) * 8 + wave] = done ? 0u : 1u;
        VM_WAIT(); __syncthreads();
        unsigned any = 0;
#pragma unroll
        for (int w = 0; w < 8; ++w) any |= flags[(T & 1) * 8 + w];
        if (!any) break;
    }
#undef SB_STAGE
    if (haveq) at_store_o(o, 1.f, (bf16*)(F.ws + WS_OSB), tok, U.head, lane);
    __syncthreads();
}

__device__ __forceinline__ int t5_bucket(int rel) {
    const int n = rel < 0 ? -rel : rel;
    const int large = 8 + (n >= 15) + (n >= 27) + (n >= 50) + (n >= 91) + (n >= 166) + (n >= 305) + (n >= 559);
    return (rel > 0 ? 16 : 0) + (n < 8 ? n : large);
}
__device__ __forceinline__ void at_stage_mask(LAS unsigned char* dst, const unsigned* mblk, int mpitch, int T, int nq, int tid, int wave) {
    const int q = (tid >> 1) < nq ? (tid >> 1) : 0;
    __builtin_amdgcn_global_load_lds(mblk + (size_t)q * mpitch + 2 * T + (tid & 1), (LAS unsigned*)(dst + wave * 256), 4, 0, 0);
}
template <int MMODE> __device__ __forceinline__ void dsa_unit(Frame& F, const AttnUnit& U, const unsigned* mblk  , int mpitch, bf16* Oout) {
    const bf16* Kb = (const bf16*)(F.ws + WS_KSA) + (size_t)U.kv_base * 1024 + U.head * 128;
    const bf16* Vb = (const bf16*)(F.ws + WS_VSA) + (size_t)U.kv_base * 1024 + U.head * 128;
    bf16* QO = (bf16*)(F.ws + WS_QSA);
    const int lane = F.lane, wave = F.wave, ql = lane & 31, hi = lane >> 5;
    const bool haveq = wave < U.nqw;
    const int wv = haveq ? wave : 0;
    const int tok = U.q_tok0 + 32 * wv + ql, qpos = U.q_pos0 + 32 * wv + ql;
    const int lim_w = haveq ? (((U.q_pos0 + 32 * wv) >> 6) + 1) * 64 : 0;
    const int T_end = (((U.q_pos0 + 32 * U.nqw - 1) >> 6) + 1);
    int ko[8], vo[4][2]; at_koffs(lane, ko); at_voffs(lane, vo);
    bf16x8 qf[8]; at_load_q(qf, QO, tok, U.head, lane);
    f32x16 o[4];
#pragma unroll
    for (int mt = 0; mt < 4; ++mt)
#pragma unroll
        for (int r = 0; r < 16; ++r) o[mt][r] = 0.f;
    float m2 = -1e30f, l = 0.f;
    unsigned dbg_chk = 0u;
    LAS float* tab = (LAS float*)(F.lds + DS_TAB);
    if (F.tid < 32) tab[F.tid] = F.in[I_REL][F.tid * 8 + U.head] * 1.4426950408889634f;
    LAS float* tabn = (LAS float*)(F.lds + DS_TABN);
    for (int i = F.tid; i < DS_TABN_N; i += NWAVES * 64) tabn[i] = F.in[I_REL][t5_bucket(i - DS_TABN_OFF) * 8 + U.head] * 1.4426950408889634f;
#define DS_STAGE(t) do { at_stage(F.lds + DS_K0 + ((t) & 3) * 16384, Kb + (size_t)(t) * 64 * 1024, wave, lane); at_stage(F.lds + DS_V0 + ((t) & 3) * 16384, Vb + (size_t)(t) * 64 * 1024, wave, lane); \
        at_stage_mask(F.lds + DS_MASK + ((t) & 3) * 2048, mblk, mpitch, (t), 32 * U.nqw, F.tid, wave); } while (0)
    DS_STAGE(0); if (T_end > 1) DS_STAGE(1); if (T_end > 2) DS_STAGE(2);
    if (T_end > 2) asm volatile("s_waitcnt vmcnt(10)" ::: "memory"); else if (T_end > 1) asm volatile("s_waitcnt vmcnt(5)" ::: "memory"); else asm volatile("s_waitcnt vmcnt(0)" ::: "memory");
    asm volatile("s_waitcnt lgkmcnt(0)" ::: "memory"); __builtin_amdgcn_s_barrier(); asm volatile("" ::: "memory");
    const float tabl = tab[ql];
    const float b15 = tab[15];
    const float C2 = 0.08838834764831845f * 1.4426950408889634f;
    for (int T = 0; T < T_end; ++T) {
        if (T + 3 < T_end) DS_STAGE(T + 3);
        if (64 * T < lim_w) {
            const LAS unsigned char* kt = F.lds + DS_K0 + (T & 3) * 16384; const LAS unsigned char* vt = F.lds + DS_V0 + (T & 3) * 16384;
            const v2u mw = MMODE == 1 ? (v2u){0xffffffffu, 0xffffffffu} : *(const LAS v2u*)(F.lds + DS_MASK + (T & 3) * 2048 + (32 * wv + ql) * 8);
            const bool far = (64 * T + 63) <= (U.q_pos0 + 32 * wv) - 559;
#pragma unroll
            for (int sub = 0; sub < 2; ++sub) {
                const unsigned wbits = (sub ? mw.y : mw.x) >> (4 * hi);
                f32x16 p = at_qk(kt, ko, sub, qf);
                if (far) {
                    const bool has = m2 > -1e29f; const float bm = b15 - (has ? m2 : 0.f);
                    float xm[16], umax;
#pragma unroll
                    for (int r = 0; r < 16; ++r) xm[r] = fmaf(p[r], C2, bm);
                    umax = xm[0];
#pragma unroll
                    for (int r = 1; r < 16; ++r) umax = fmaxf(umax, xm[r]);
                    umax = fmaxf(umax, xhalf(umax));
                    const unsigned wsel = wbits & 0x0f0f0f0fu, wany = wsel | (unsigned)__shfl_xor((int)wsel, 32);
                    unsigned pw[8];
#pragma unroll
                    for (int k = 0; k < 8; ++k) { const int c0 = 2 * (k & 1) + 8 * (k >> 1);
                        const unsigned mlo = (unsigned)__builtin_amdgcn_sbfe((int)wbits, c0, 1), mhi = (unsigned)__builtin_amdgcn_sbfe((int)wbits, c0 + 1, 1);
                        pw[k] = pk2(__builtin_amdgcn_exp2f(xm[2 * k]), __builtin_amdgcn_exp2f(xm[2 * k + 1])) & __builtin_amdgcn_perm(mhi, mlo, 0x05040100u); }
                    if (!__any(umax > 8.f || (!has && wany != 0u))) {
#pragma unroll
                        for (int k = 0; k < 8; ++k) l = __builtin_amdgcn_fdot2_f32_bf16(__builtin_bit_cast(bf16x2_, pw[k]), __builtin_bit_cast(bf16x2_, 0x3f803f80u), l, false);
                        at_pv_w(o, vt, vo, sub, pw);
                        continue;
                    }
                }
                float pmax = -__builtin_inff();
                if (far) {
#pragma unroll
                    for (int r = 0; r < 16; ++r) { const bool sel = (wbits >> ((r & 3) + 8 * (r >> 2))) & 1u; p[r] = sel ? fmaf(p[r], C2, b15) : -__builtin_inff(); pmax = fmaxf(pmax, p[r]); }
                } else {
                    int ti = 64 * T + 32 * sub + 4 * hi - qpos + DS_TABN_OFF; ti = ti < 0 ? 0 : (ti > DS_TABN_N - 28 ? DS_TABN_N - 28 : ti);
                    const LAS float* tb = tabn + ti;
#pragma unroll
                    for (int r = 0; r < 16; ++r) { const bool sel = (wbits >> ((r & 3) + 8 * (r >> 2))) & 1u;
                        const float bias = tb[(r & 3) + 8 * (r >> 2)];
                        p[r] = sel ? fmaf(p[r], C2, bias) : -__builtin_inff(); pmax = fmaxf(pmax, p[r]); }
                }
                pmax = fmaxf(pmax, xhalf(pmax));
                if (!__all(pmax - m2 <= 8.f)) {
                    const float mn = fmaxf(m2, pmax), alpha = __builtin_amdgcn_exp2f(m2 - mn);
#pragma unroll
                    for (int mt = 0; mt < 4; ++mt)
#pragma unroll
                        for (int r = 0; r < 16; ++r) o[mt][r] *= alpha;
                    l *= alpha; m2 = mn;
                }
                float ps = 0.f;
#pragma unroll
                for (int r = 0; r < 16; ++r) { p[r] = __builtin_amdgcn_exp2f(p[r] - m2); ps += p[r]; }
                l += ps;
                at_pv(o, vt, vo, sub, p);
            }
        }
        { const int after = T_end - 2 - T;
          if (after >= 2) asm volatile("s_waitcnt vmcnt(10)" ::: "memory"); else if (after == 1) asm volatile("s_waitcnt vmcnt(5)" ::: "memory"); else asm volatile("s_waitcnt vmcnt(0)" ::: "memory"); }
        asm volatile("s_waitcnt lgkmcnt(0)" ::: "memory"); __builtin_amdgcn_s_barrier(); asm volatile("" ::: "memory");
    }
#undef DS_STAGE
    const float lt = l + xhalf(l);
    if (haveq) at_store_o(o, lt > 0.f ? 1.f / lt : 0.f, Oout, tok, U.head, lane);
    __syncthreads();
}
typedef float f32x2i __attribute__((ext_vector_type(2)));
typedef int i32x16i __attribute__((ext_vector_type(16)));
constexpr int IX_CAP = 512, IX_BITS = 131072;
__device__ __forceinline__ unsigned f2key(float f) { const unsigned u = __float_as_uint(f); return u ^ ((unsigned)((int)u >> 31) | 0x80000000u); }
__device__ __forceinline__ int ix_select(LAS unsigned* bk, LAS unsigned short* bi, int n, int nbits, int lane, unsigned& bound_out) {
    unsigned key[8]; unsigned idx[8];
#pragma unroll
    for (int i = 0; i < 8; ++i) { const int e = lane + 64 * i; const bool v = e < n; key[i] = v ? bk[e] : 0u; idx[i] = v ? (unsigned)bi[e] : 0u; }
    unsigned prefix = 0u;
    for (int bit = 31; bit >= 32 - nbits; --bit) { const unsigned cand = prefix | (1u << bit); int c = 0;
#pragma unroll
        for (int i = 0; i < 8; ++i) c += __popcll(__ballot(key[i] >= cand));
        if (c >= 256) prefix = cand; }
    const unsigned long long lt = (1ull << lane) - 1ull;
    bool keep[8];
    if (nbits == 32) {
        int ngt = 0;
#pragma unroll
        for (int i = 0; i < 8; ++i) ngt += __popcll(__ballot(key[i] > prefix));
        const int need = 256 - ngt; int eqbase = 0;
#pragma unroll
        for (int i = 0; i < 8; ++i) { const bool eq = (key[i] == prefix) && (key[i] != 0u); const unsigned long long m = __ballot(eq);
            const int rank = eqbase + __popcll(m & lt); keep[i] = (key[i] > prefix) || (eq && rank < need); eqbase += __popcll(m); }
        bound_out = prefix;
    } else {
#pragma unroll
        for (int i = 0; i < 8; ++i) keep[i] = (key[i] >= prefix) && (key[i] != 0u);
        bound_out = prefix - 1u;
    }
    int base = 0;
#pragma unroll
    for (int i = 0; i < 8; ++i) { const unsigned long long m = __ballot(keep[i]); const int pos = base + __popcll(m & lt);
        if (keep[i]) { bk[pos] = key[i]; bi[pos] = (unsigned short)idx[i]; } base += __popcll(m); }
    return base;
}
struct CvState { f32x4 a, b; int k; };
__device__ __forceinline__ bool cv_step(Frame& F, CvState& cv) {
    const size_t NGT = (size_t)F.G * (NWAVES * 64), gt = (size_t)F.c * (NWAVES * 64) + F.tid; const int KT = (int)(((size_t)8388608 + NGT - 1) / NGT);
    if (cv.k > 2 * KT) return false;
    if (cv.k > 0) { const int kk = cv.k - 1; const bool t = kk >= KT; const size_t i = gt + (size_t)(t ? kk - KT : kk) * NGT;
        if (i < (size_t)8388608) { const size_t e = i * 8, sq = e >> 21, rem = e & 2097151;
            v4u o; o.x = pk2(cv.a[0], cv.a[1]); o.y = pk2(cv.a[2], cv.a[3]); o.z = pk2(cv.b[0], cv.b[1]); o.w = pk2(cv.b[2], cv.b[3]);
            __builtin_nontemporal_store(o, (v4u*)((bf16*)(F.ws + (t ? WS_VSA : WS_KSA)) + ((size_t)MP + sq * SKV) * 1024 + rem)); } }
    if (cv.k < 2 * KT) { const int kk = cv.k; const bool t = kk >= KT; const size_t i = gt + (size_t)(t ? kk - KT : kk) * NGT;
        if (i < (size_t)8388608) { const float* src = (t ? F.in[I_CSAV] : F.in[I_CSAK]) + i * 8; cv.a = *(const GAS f32x4*)src; cv.b = *(const GAS f32x4*)(src + 4); } }
    ++cv.k;
    return true;
}
__device__ __forceinline__ void ix_unit(Frame& F, int kv_base, int q_tok0, int lim, unsigned* mask0, int mpitch, CvState& cv) {
    const int lane = F.lane, wave = F.wave, kl = lane & 31, hh = lane >> 5;
    const bf16* QIX = (const bf16*)(F.ws + WS_QIX); const float* WIX = (const float*)(F.ws + WS_WIX);
    const bf16* kp = (const bf16*)(F.ws + WS_KIX) + (size_t)kv_base * 64 + kl * 64 + 8 * hh;
    bf16x8 qa[2][4]; float wvv[2][16];
#pragma unroll
    for (int p = 0; p < 2; ++p) {
        const int g = kl >> 3, h1 = (kl >> 2) & 1, i = kl & 3;
        const bf16* qp = QIX + (size_t)(q_tok0 + 4 * wave + 2 * p + h1) * 1024 + (4 * g + i) * 64 + 8 * hh;
#pragma unroll
        for (int ks = 0; ks < 4; ++ks) qa[p][ks] = *(const GAS bf16x8*)(qp + 16 * ks);
        const float* wp = WIX + (size_t)(q_tok0 + 4 * wave + 2 * p + hh) * 16;
#pragma unroll
        for (int r4 = 0; r4 < 4; ++r4) { const f32x4 w4 = *(const GAS f32x4*)(wp + 4 * r4);
#pragma unroll
            for (int j = 0; j < 4; ++j) wvv[p][4 * r4 + j] = w4[j] * 0.03125f; }
    }
    int cnt0 = 0, cnt1 = 0, cnt2 = 0, cnt3 = 0; unsigned bound[2] = {0u, 0u};
    LAS unsigned char* wb = F.lds + wave * 12288;
    const int nsubs = lim >> 5;
#define IX_LD(KB, SUB) do { _Pragma("unroll") for (int ks_ = 0; ks_ < 4; ++ks_) KB[ks_] = *(const GAS bf16x8*)(kp + (size_t)(SUB) * 2048 + 16 * ks_); } while (0)
#define IX_MF(dst, P, KB) do { _Pragma("unroll") for (int r_ = 0; r_ < 16; ++r_) dst[r_] = 0.f; _Pragma("unroll") for (int ks_ = 0; ks_ < 4; ++ks_) dst = MFMA32(qa[P][ks_], KB[ks_], dst); } while (0)
#define IX_PROC(A, P, SUB) do { float s_; { i32x16i iv_ = __builtin_bit_cast(i32x16i, A); i32x16i zz_; _Pragma("unroll") for (int r_ = 0; r_ < 16; ++r_) zz_[r_] = 0; \
            iv_ = __builtin_elementwise_max(iv_, zz_); const f32x16 rl_ = __builtin_bit_cast(f32x16, iv_); f32x2i s2_ = {0.f, 0.f}; \
            _Pragma("unroll") for (int r_ = 0; r_ < 16; r_ += 2) { const f32x2i x_ = {rl_[r_], rl_[r_ + 1]}; const f32x2i w2_ = {wvv[P][r_], wvv[P][r_ + 1]}; s2_ = w2_ * x_ + s2_; } s_ = s2_.x + s2_.y; } \
        const unsigned kpos_ = (unsigned)(32 * (SUB) + kl); const unsigned key_ = f2key(s_); const bool pass_ = key_ > bound[P]; const unsigned long long m_ = __ballot(pass_); \
        if (m_) { const unsigned mlo_ = (unsigned)m_, mhi_ = (unsigned)(m_ >> 32); int& cA_ = (P == 0 ? cnt0 : cnt2); int& cB_ = (P == 0 ? cnt1 : cnt3); \
            const int pos_ = (hh ? cB_ : cA_) + __popc((hh ? mhi_ : mlo_) & ((1u << kl) - 1u)); LAS unsigned char* qb_ = wb + (2 * P + hh) * 3072; \
            if (pass_) { ((LAS unsigned*)qb_)[pos_] = key_; ((LAS unsigned short*)(qb_ + 2048))[pos_] = (unsigned short)kpos_; } \
            cA_ += __popc(mlo_); cB_ += __popc(mhi_); \
            if (cA_ > IX_CAP - 32) { unsigned b_; LAS unsigned char* q0_ = wb + (2 * P) * 3072; cA_ = ix_select((LAS unsigned*)q0_, (LAS unsigned short*)(q0_ + 2048), cA_, 12, lane, b_); \
                if (cA_ > 384) cA_ = ix_select((LAS unsigned*)q0_, (LAS unsigned short*)(q0_ + 2048), cA_, 32, lane, b_); if (!hh) bound[P] = b_; } \
            if (cB_ > IX_CAP - 32) { unsigned b_; LAS unsigned char* q1_ = wb + (2 * P + 1) * 3072; cB_ = ix_select((LAS unsigned*)q1_, (LAS unsigned short*)(q1_ + 2048), cB_, 12, lane, b_); \
                if (cB_ > 384) cB_ = ix_select((LAS unsigned*)q1_, (LAS unsigned short*)(q1_ + 2048), cB_, 32, lane, b_); if (hh) bound[P] = b_; } } } while (0)
#define IX_STEP(KCUR, KFILL, SUB) do { IX_LD(KFILL, (SUB) + 1);          \
        f32x16 a0_, a1_; IX_MF(a0_, 0, KCUR); IX_MF(a1_, 1, KCUR); IX_PROC(a0_, 0, SUB); IX_PROC(a1_, 1, SUB); } while (0)
    bf16x8 kA[4], kB[4];
    IX_LD(kA, 0);
    for (int sub = 0; sub < nsubs; sub += 2) { IX_STEP(kA, kB, sub); IX_STEP(kB, kA, sub + 1); if ((sub & 2) == 0) cv_step(F, cv); }
#undef IX_STEP
#undef IX_LD
#undef IX_MF
#undef IX_PROC
    LAS unsigned* bits = (LAS unsigned*)(F.lds + IX_BITS + wave * 2048);
    const int nw = lim >> 5;
#pragma unroll 1
    for (int q4 = 0; q4 < 4; ++q4) {
        int n = q4 == 0 ? cnt0 : q4 == 1 ? cnt1 : q4 == 2 ? cnt2 : cnt3;
        LAS unsigned char* qb = wb + q4 * 3072; unsigned b;
        if (n > 256) n = ix_select((LAS unsigned*)qb, (LAS unsigned short*)(qb + 2048), n, 32, lane, b);
        for (int w = lane; w < nw; w += 64) bits[w] = 0u;
        for (int e = lane; e < n; e += 64) { const unsigned ix = ((LAS unsigned short*)(qb + 2048))[e]; __hip_atomic_fetch_or(bits + (ix >> 5), 1u << (ix & 31), __ATOMIC_RELAXED, __HIP_MEMORY_SCOPE_WORKGROUP); }
        unsigned* mr = mask0 + (size_t)(4 * wave + q4) * mpitch;
        for (int w = lane; w < nw; w += 64) mr[w] = bits[w];
    }
}
constexpr int N_PHASES = 12;
struct Args { const float* in[25]; float* out; unsigned char* ws; int ph_lo, ph_hi; };
__global__ void __launch_bounds__(NWAVES * 64, 2) fwd_kernel(Args args) {
    extern __shared__ __attribute__((aligned(16))) unsigned char lds[];
    Frame F;
    F.lds = (LAS unsigned char*)lds; F.ws = args.ws; F.out = args.out;
    F.tid = threadIdx.x; F.lane = F.tid & 63; F.wave = __builtin_amdgcn_readfirstlane(F.tid >> 6);
    F.G = gridDim.x; F.c = blockIdx.x;
#pragma unroll
    for (int i = 0; i < 25; ++i) F.in[i] = args.in[i];
    volatile LAS unsigned* MISC = (volatile LAS unsigned*)(F.lds + MISC_OFF);
    if (F.tid < 64) MISC[F.tid] = 0u;
    __syncthreads();
    unsigned* ctl = (unsigned*)(F.ws + WS_CTL);
    XcdBarrier bar; bar.bar = ctl + CW_BAR; bar.x = 0; bar.st = nullptr;
    const int lo = args.ph_lo, hi = args.ph_hi;
    const bool one_launch = (hi - lo) > 1;
    if (one_launch) bar = xcd_barrier_post(ctl + CW_BAR, MISC + 8);
#define IN(k) (lo <= (k) && (k) < hi)
#define SEAM(k) do { if (IN(k) && IN((k) + 1)) xcd_barrier(bar); } while (0)

    if (IN(0)) { p0_prologue(F); } SEAM(0);
    if (IN(1)) { norm_mod_rows(F, F.in[I_XP], F.in[I_XS], F.in[I_GMIX], 0, 1, 0, MT, F.c, F.G); } SEAM(1);
    if (IN(2)) {
      {
        pg8::Gemm g{(const bf16*)(F.ws + WS_HB), (const bf16*)(F.ws + WS_WCAT), MT, NCAT, DM}; pg8::StaticOrder S; S.init(MT, NCAT, F.G, F.c);
        pg8::EpiG1 E{F.ws, F.out};
        pg8::gemm_phase<pg8::EpiG1, pg8::StaticOrder, true, true>(F.lds + RING_OFF, g, S, E);
      }
    } SEAM(2);
    if (IN(3)) {
      {
        CvState cv; cv.k = 0; cv.a = (f32x4){0.f, 0.f, 0.f, 0.f}; cv.b = cv.a;
        const int sb_n = (F.G == 256) ? (F.c < 64 ? 2 : 6) : 0, sb_0 = (F.G == 256) ? (F.c < 64 ? 2 * F.c : 128 + 6 * (F.c - 64)) : F.c;
        for (int u = sb_0, k_ = 0; u < 1280 && (F.G != 256 || k_ < sb_n); u += (F.G == 256 ? 1 : F.G), ++k_) {
            AttnUnit U;
            if (u < 1024) { const int b = u >> 9, qb = u & 63; U.kv_base = b * SEQ; U.q_tok0 = b * SEQ + 256 * qb; U.q_pos0 = 256 * qb; U.nqw = 8; U.head = (u >> 6) & 7; U.ck = nullptr; U.cv = nullptr; }
            else { const int v = u - 1024, s = v >> 3; U.kv_base = MP + s * SKV; U.q_tok0 = MP + 64 * s; U.q_pos0 = PAST; U.nqw = 2; U.head = v & 7;
                   U.ck = F.in[I_CSBK] + (size_t)s * PAST * 1024; U.cv = F.in[I_CSBV] + (size_t)s * PAST * 1024; }
            sb_unit(F, U);
        }
        for (int j = F.c; j < 512; j += F.G) {
            const int b = j >> 8, jj = j & 255;
#pragma unroll 1
            for (int k = 0; k < 2; ++k) { const int hc = k ? 511 - jj : jj, q0 = 32 * hc;
                ix_unit(F, b * SEQ, b * SEQ + q0, 64 * ((hc >> 1) + 1), (unsigned*)(F.ws + WS_MASKP) + (size_t)(b * SEQ + q0) * MASKP_PITCH, MASKP_PITCH, cv); }
        }
        for (int v = F.c; v < 64; v += F.G) { const int s = v >> 1, half = v & 1;
            ix_unit(F, MP + s * SKV, MP + 64 * s + 32 * half, SKV, (unsigned*)(F.ws + WS_MASKS) + (size_t)(64 * s + 32 * half) * MASKS_PITCH, MASKS_PITCH, cv); }
        for (int g_ = 0; g_ < 65536; ++g_) if (!cv_step(F, cv)) break;
      }
    } SEAM(3);
    if (IN(4)) {
      {
        for (int it = F.c; it < 512; it += F.G) {
            const int pu = (F.G == 256) ? ((2 * (it & 7) + (it >> 8)) << 5) + ((it >> 3) & 31) : it;
            const int b = pu >> 8, i = pu & 31;
#pragma unroll 1
            for (int k = 0; k < 2; ++k) { const int qb = k ? 63 - i : i;
                AttnUnit U; U.kv_base = b * SEQ; U.q_tok0 = b * SEQ + 256 * qb; U.q_pos0 = 256 * qb; U.nqw = 8; U.head = (pu >> 5) & 7; U.ck = nullptr; U.cv = nullptr;
                dsa_unit<0>(F, U, (const unsigned*)(F.ws + WS_MASKP) + (size_t)(b * SEQ + 256 * qb) * MASKP_PITCH, MASKP_PITCH, (bf16*)(F.ws + WS_OSA)); }
        }
        for (int v = F.c; v < 256; v += F.G) { const int s = v >> 3;
            AttnUnit U; U.kv_base = MP + s * SKV; U.q_tok0 = MP + 64 * s; U.q_pos0 = PAST; U.nqw = 2; U.head = v & 7; U.ck = nullptr; U.cv = nullptr;
            dsa_unit<0>(F, U, (const unsigned*)(F.ws + WS_MASKS) + (size_t)(64 * s) * MASKS_PITCH, MASKS_PITCH, (bf16*)(F.ws + WS_OSA)); }
      }
    } SEAM(4);
    if (IN(5)) {
      {
        { pg8::Gemm g{(const bf16*)(F.ws + WS_OSB), (const bf16*)(F.ws + WS_WBRSB), MT, DM, WSB}; pg8::StaticOrder S; S.init(MT, DM, F.G, F.c);
          pg8::EpiBr1 E{F.ws}; pg8::gemm_phase<pg8::EpiBr1, pg8::StaticOrder, true, true>(F.lds + RING_OFF, g, S, E); }
        VM_WAIT(); __syncthreads();
        { pg8::Gemm g{(const bf16*)(F.ws + WS_OSA), (const bf16*)(F.ws + WS_WBRSA), MT, DM, WSB}; pg8::StaticOrder S; S.init(MT, DM, F.G, F.c);
          pg8::EpiBr2 E{F.ws}; pg8::gemm_phase<pg8::EpiBr2, pg8::StaticOrder, true, true>(F.lds + RING_OFF, g, S, E); }
      }
    } SEAM(5);
    const bool split = one_launch && F.G > 64;
    constexpr int P7_EARLY = MP;
    if (IN(6)) {
      {
        pg8::Gemm g{(const bf16*)(F.ws + WS_MRG), (const bf16*)(F.ws + WS_WOUT), MT, DM, DM};
        pg8::EpiRes E{F.in[I_XP], F.in[I_XS], (float*)(F.ws + WS_XMID), (const float*)(F.ws + WS_MOD), 2};
        { pg8::StaticOrder S; S.init(split ? MP : MT, DM, F.G, F.c); pg8::gemm_phase<pg8::EpiRes, pg8::StaticOrder, true, true>(F.lds + RING_OFF, g, S, E); }
        if (split) {
            VM_WAIT(); __syncthreads();
            if (F.tid == 0) xcd_count_in(bar, ctl + CW_P6L, ctl + CW_P6);
            if (F.c < 64) { pg8::TailOrder S{MP / 256, DM / 256, F.c}; pg8::gemm_phase<pg8::EpiRes, pg8::TailOrder, true, true>(F.lds + RING_OFF, g, S, E); }
            else {
                if (F.tid == 0) { XB_SPIN(xb_ld(ctl + CW_P6) < (unsigned)F.G, bar.bar); __builtin_amdgcn_fence(__ATOMIC_ACQUIRE, "agent"); VM_WAIT(); }
                __syncthreads();
                norm_mod_rows(F, (const float*)(F.ws + WS_XMID), (const float*)(F.ws + WS_XMID) + (size_t)MP * DM, F.in[I_GFFN], 3, 4, 0, P7_EARLY, F.c - 64, F.G - 64);
            }
        }
      }
    } SEAM(6);
    if (IN(7)) { norm_mod_rows(F, (const float*)(F.ws + WS_XMID), (const float*)(F.ws + WS_XMID) + (size_t)MP * DM, F.in[I_GFFN], 3, 4, split ? P7_EARLY : 0, MT, F.c, F.G); } SEAM(7);
    if (IN(8)) {
      {
        pg8::Gemm g{(const bf16*)(F.ws + WS_HB), (const bf16*)(F.ws + WS_WUP), MT, NUP, DM}; pg8::StaticOrder S; S.init(MT, NUP, F.G, F.c);
        pg8::EpiUpConv E{F.ws, F.out, F.in[I_CONVW], F.in[I_CONVB], F.in[I_CONVST], (LAS float*)(F.lds + HALO_OFF)};
        pg8::gemm_phase<pg8::EpiUpConv, pg8::StaticOrder, true, true>(F.lds + RING_OFF, g, S, E);
      }
    } SEAM(8);
    if (IN(9)) { conv_fix(F); } SEAM(9);
    if (IN(10)) {
      {
        pg8::Gemm g{(const bf16*)(F.ws + WS_ACT), (const bf16*)(F.ws + WS_WDOWN), MT, DM, DFF};
        pg8::EpiRes E{(const float*)(F.ws + WS_XMID), (const float*)(F.ws + WS_XMID) + (size_t)MP * DM, F.out + O_Y, (const float*)(F.ws + WS_MOD), 5};
        { pg8::StaticOrder S; S.init(split ? MP : MT, DM, F.G, F.c); pg8::gemm_phase<pg8::EpiRes, pg8::StaticOrder, true, true>(F.lds + RING_OFF, g, S, E); }
        if (split) {
            VM_WAIT(); __syncthreads();
            if (F.tid == 0) xcd_count_in(bar, ctl + CW_P10L, ctl + CW_P10);
            if (F.c < 64) { pg8::TailOrder S{MP / 256, DM / 256, F.c}; pg8::gemm_phase<pg8::EpiRes, pg8::TailOrder, true, true>(F.lds + RING_OFF, g, S, E); }
            else {
                if (F.tid == 0) { XB_SPIN(xb_ld(ctl + CW_P10) < (unsigned)F.G, bar.bar); __builtin_amdgcn_fence(__ATOMIC_ACQUIRE, "agent"); VM_WAIT(); }
                __syncthreads();
                final_norm_rows(F, 0, MP, F.c - 64, F.G - 64);
            }
        }
      }
    } SEAM(10);
    if (IN(11)) { final_norm_rows(F, split ? MP : 0, MT, F.c, F.G); }
#undef IN
#undef SEAM
}

extern "C" void kernel_launch(void* const* d_in, const int* in_sizes, int n_in, void* d_out, int out_size, void* d_ws, size_t ws_size, hipStream_t stream) {
    static int grid = 0;
    if (grid == 0) {
        if (n_in != 25 || in_sizes[0] != MP * DM || (size_t)out_size != O_END || ws_size < WS_END) {
            fprintf(stderr, "kernel_launch: built for 25 inputs, out of %zu floats, >= %zu bytes of workspace; got n_in %d, in0 %d, out %d, ws %zu; nothing launched\n", (size_t)O_END, (size_t)WS_END, n_in, n_in > 0 ? in_sizes[0] : -1, out_size, ws_size); grid = -1; return; }
        int dev = 0, cus = 0, per_cu = 0;
        if (hipGetDevice(&dev) != hipSuccess || hipDeviceGetAttribute(&cus, hipDeviceAttributeMultiprocessorCount, dev) != hipSuccess) { fprintf(stderr, "kernel_launch: device query failed\n"); grid = -1; return; }
        if (hipFuncSetAttribute((const void*)fwd_kernel, hipFuncAttributeMaxDynamicSharedMemorySize, LDS_BYTES) != hipSuccess) { fprintf(stderr, "kernel_launch: hipFuncSetAttribute failed\n"); grid = -1; return; }
        if (hipOccupancyMaxActiveBlocksPerMultiprocessor(&per_cu, (const void*)fwd_kernel, NWAVES * 64, LDS_BYTES) != hipSuccess || per_cu < 1)
            fprintf(stderr, "kernel_launch: note: occupancy query reports %d workgroups per CU\n", per_cu);
        (void)hipGetLastError();
        grid = cus;
    }
    if (grid < 0) return;
    if (hipMemsetAsync((char*)d_ws + WS_CTL, 0, CTL_ZERO_BYTES, stream) != hipSuccess) { fprintf(stderr, "kernel_launch: memset failed\n"); return; }
    Args a{};
    for (int i = 0; i < 25; ++i) a.in[i] = (const float*)d_in[i];
    a.out = (float*)d_out; a.ws = (unsigned char*)d_ws;
    a.ph_lo = 0; a.ph_hi = N_PHASES;
    hipLaunchKernelGGL(fwd_kernel, dim3(grid), dim3(NWAVES * 64), LDS_BYTES, stream, a);
    const hipError_t le = hipPeekAtLastError();
    if (le != hipSuccess) fprintf(stderr, "kernel_launch: launch failed: %s\n", hipGetErrorName(le));
}
```

```cpp
#include <hip/hip_runtime.h>
#include <cstdio>
#include <cstdint>

constexpr int DM = 2048, SEQ = 16384, NSAMP = 32, DSEQ = 64, PAST = 2048, SKV = PAST + DSEQ;
constexpr int MP = 2 * SEQ, MS = NSAMP * DSEQ, MT = MP + MS;
constexpr int KVR = MP + NSAMP * SKV;
constexpr int NCAT = 11520, NGATE0 = 7424, DFF = 5632, NUP = 2 * DFF, WSB = 1024;
constexpr float EPS = 1e-6f;
constexpr size_t O_Y = 0, O_PSBK = 71303168, O_PSBV = 104857600, O_PSAK = 138412032, O_PSAV = 171966464, O_PIDX = 205520896, O_PCONV = 207618048,
                 O_SSBK = 207640576, O_SSBV = 209737728, O_SSAK = 211834880, O_SSAV = 213932032, O_SIDX = 216029184, O_SCONV = 216160256, O_END = 216520704;
constexpr size_t MiB = 1u << 20;
constexpr size_t WS_CTL = 0, CTL_ZERO_BYTES = 1 * MiB;
constexpr size_t WS_MOD = 1 * MiB;
constexpr size_t WS_WDOWN = 3 * MiB;
constexpr size_t WS_G = 25 * MiB;
constexpr size_t WS_XMID = WS_G;
constexpr size_t WS_KSB = 297 * MiB, WS_VSB = 493 * MiB, WS_KSA = 689 * MiB, WS_VSA = 885 * MiB;
constexpr size_t WS_TMP = 297 * MiB;
constexpr size_t WS_ACT = 297 * MiB;
constexpr size_t WS_TAIL = 700 * MiB;
constexpr size_t WS_HEAD = 708 * MiB;
constexpr size_t WS_HB = 1081 * MiB;
constexpr size_t WS_QSB = 1217 * MiB, WS_QSA = 1285 * MiB, WS_QIX = 1353 * MiB;
constexpr size_t WS_OSB = WS_HB, WS_OSA = WS_HB + 68 * MiB;
constexpr size_t WS_MRG = WS_QSB;
constexpr size_t WS_KIX = 1421 * MiB;
constexpr size_t WS_WIX = 1434 * MiB;
constexpr size_t WS_MASKP = 1437 * MiB;
constexpr size_t WS_MASKS = 1501 * MiB;
constexpr size_t WS_WCAT = 1502 * MiB;
constexpr size_t WS_WBRSB = 1547 * MiB, WS_WBRSA = 1551 * MiB, WS_WOUT = 1555 * MiB, WS_WUP = 1563 * MiB;
constexpr size_t WS_END = 1607 * MiB;
static_assert(WS_ACT + (size_t)MT * DFF * 2 <= WS_TAIL && WS_TAIL + (size_t)128 * 44 * 2 * 128 * 4 <= WS_HEAD && WS_HEAD + (size_t)128 * 44 * 4 * 128 * 4 <= WS_HB && WS_VSA + (size_t)KVR * 2048 <= WS_HB, "ws map");
constexpr int MASKP_PITCH = 512, MASKS_PITCH = 96;
constexpr int CW_BAR = 4096, CW_P10 = 8192, CW_P6 = 8256, CW_P6L = 9216, CW_P10L = 10240;
constexpr int RING_OFF = 0, RING_BYTES = 131072;
constexpr int LDS_BYTES = 163840;
constexpr int HALO_OFF = RING_BYTES;
constexpr int MISC_OFF = LDS_BYTES - 256;

#define GAS __attribute__((address_space(1)))
#define LAS __attribute__((address_space(3)))
typedef unsigned short bf16;
typedef unsigned v4u __attribute__((ext_vector_type(4)));
typedef unsigned v2u __attribute__((ext_vector_type(2)));
typedef float f32x4 __attribute__((ext_vector_type(4)));
typedef float f32x16 __attribute__((ext_vector_type(16)));
typedef short bf16x8 __attribute__((ext_vector_type(8)));
typedef short s16x4 __attribute__((ext_vector_type(4)));
#define LDS_WAIT() asm volatile("s_waitcnt lgkmcnt(0)" ::: "memory")
#define VM_WAIT() asm volatile("s_waitcnt vmcnt(0)" ::: "memory")
typedef float f32x2_ __attribute__((ext_vector_type(2)));
typedef __bf16 bf16x2_ __attribute__((ext_vector_type(2)));
__device__ __forceinline__ unsigned pk2(float lo, float hi) { const f32x2_ v = {lo, hi}; return __builtin_bit_cast(unsigned, __builtin_convertvector(v, bf16x2_)); }
__device__ __forceinline__ float bf2f(unsigned b16) { return __uint_as_float(b16 << 16); }
__device__ __forceinline__ float wave_sum(float v) {
#pragma unroll
    for (int o = 1; o < 64; o <<= 1) v += __shfl_xor(v, o);
    return v;
}
__device__ __forceinline__ float sigmoidf_(float x) { return __builtin_amdgcn_rcpf(1.f + __builtin_amdgcn_exp2f(-1.4426950408889634f * x)); }
__device__ __forceinline__ int mod_row(int row) { return row < MP ? (row >> 14) : 2 + ((row - MP) >> 6); }
__device__ __forceinline__ int kv_row(int row) { return row < MP ? row : MP + ((row - MP) >> 6) * SKV + PAST + ((row - MP) & 63); }
namespace pg8 {
#define PG8_LAS __attribute__((address_space(3)))
typedef unsigned short bf16_t;
typedef short bf16x8 __attribute__((ext_vector_type(8)));
typedef float f32x4 __attribute__((ext_vector_type(4)));
typedef unsigned u32x4 __attribute__((ext_vector_type(4)));
constexpr int BM = 256, BK = 64, HALF = 128, HTB = HALF * BK * 2  , STAGE_BYTES = 8 * HTB, NXCD = 8, WGM = 8;

__host__ __device__ __forceinline__ int lds_byte(int r, int c) { const int st = (r >> 4) * 2 + (c >> 5), rr = r & 15, cc = c & 31, ob = rr * 64 + cc * 2; return st * 1024 + (ob ^ (((ob >> 9) & 1) << 5)); }
__host__ __device__ __forceinline__ void stage_rc(int b, int& R, int& C) { const int st = b / 1024, sb = b % 1024, swz = sb ^ (((sb >> 9) & 1) << 5); R = (st >> 1) * 16 + swz / 64; C = (st & 1) * 32 + (swz % 64) / 2; }
__host__ __device__ __forceinline__ int perm32(int rho) { const int n = rho >> 4, i = rho & 15; return 8 * (i >> 2) + 4 * n + (i & 3); }

struct Unit { int pm, pn; };
struct Gemm { const bf16_t* A; const bf16_t* Bt; int M, N, K; };

struct StaticOrder {
    int nM, nN, nwg, G, c;
    __host__ __device__ void init(int M, int N, int G_, int c_) { nM = M / BM; nN = N / BM; nwg = nM * nN; G = G_; c = c_; }
    __host__ __device__ bool next(int i, Unit& u) const {
        const long L = (long)i * G + c; if (L >= nwg) return false;
        int wgid = (int)L; { const int q = nwg / NXCD, r = nwg % NXCD, xcd = wgid % NXCD, off = wgid / NXCD; wgid = (xcd < r ? xcd * (q + 1) : r * (q + 1) + (xcd - r) * q) + off; }
        const int nig = WGM * nN, gid = wgid / nig, fm = gid * WGM, gsz = (nM - fm) < WGM ? (nM - fm) : WGM;
        u.pm = fm + ((wgid % nig) % gsz); u.pn = (wgid % nig) / gsz; return true;
    }
    __device__ __forceinline__ void a_ready(const Unit&) const {}
    __device__ __forceinline__ void done(const Unit&) const {}
};
struct TailOrder {
    int pm0, nN, c;
    __host__ __device__ bool next(int i, Unit& u) const { if (i > 0 || c >= 8 * nN) return false; u.pm = pm0 + (c & 7); u.pn = c >> 3; return true; }
    __device__ __forceinline__ void a_ready(const Unit&) const {}
    __device__ __forceinline__ void done(const Unit&) const {}
};

__device__ __forceinline__ unsigned cvt_pk_bf16(float lo, float hi) { return ::pk2(lo, hi); }
__device__ __forceinline__ float sigm(float x) { return __builtin_amdgcn_rcpf(1.f + __builtin_amdgcn_exp2f(-1.4426950408889634f * x)); }
__device__ __forceinline__ u32x4 pack8bf(const f32x4 v0, const f32x4 v1) { u32x4 w; w.x = cvt_pk_bf16(v0[0], v0[1]); w.y = cvt_pk_bf16(v0[2], v0[3]); w.z = cvt_pk_bf16(v1[0], v1[1]); w.w = cvt_pk_bf16(v1[2], v1[3]); return w; }
__device__ __forceinline__ void unpack8bf(const u32x4 w, f32x4& a, f32x4& b) {
    a[0] = __uint_as_float(w.x << 16); a[1] = __uint_as_float(w.x & 0xffff0000u); a[2] = __uint_as_float(w.y << 16); a[3] = __uint_as_float(w.y & 0xffff0000u);
    b[0] = __uint_as_float(w.z << 16); b[1] = __uint_as_float(w.z & 0xffff0000u); b[2] = __uint_as_float(w.w << 16); b[3] = __uint_as_float(w.w & 0xffff0000u); }

struct EpiG1 {
    static constexpr bool PERM = true, AFTER_DRAIN = false;
    unsigned char* ws; float* out;
    __device__ __forceinline__ void operator()(const f32x4 (&acc)[2][2][4][2], const Unit& u, int wr, int wc, int fr, int fq) const {
        const int pn = u.pn, pm = u.pm; const bool samp = pm >= 128;
        const int colw = wc * 32 + 8 * fq, row0 = pm * BM + wr * 64 + fr;
        if (pn >= 29) {
            bf16_t* G = (bf16_t*)(ws + WS_G) + (pn - 29) * 256 + colw;
#pragma unroll
            for (int ai = 0; ai < 2; ++ai)
#pragma unroll
                for (int m = 0; m < 4; ++m) { bf16_t* rowp = G + (size_t)(row0 + ai * HALF + m * 16) * 4096;
#pragma unroll
                    for (int bj = 0; bj < 2; ++bj) { f32x4 v0 = acc[ai][bj][m][0], v1 = acc[ai][bj][m][1];
#pragma unroll
                        for (int j = 0; j < 4; ++j) { v0[j] = sigm(v0[j]); v1[j] = sigm(v1[j]); }
                        __builtin_nontemporal_store(pack8bf(v0, v1), (u32x4*)(rowp + bj * HALF)); } }
            return;
        }
        if (pn == 28) {
            if (colw >= 80) return;
#pragma unroll
            for (int ai = 0; ai < 2; ++ai)
#pragma unroll
                for (int m = 0; m < 4; ++m) { const int row = row0 + ai * HALF + m * 16; const f32x4 v0 = acc[ai][0][m][0], v1 = acc[ai][0][m][1];
                    if (colw < 64) {
                        const int kvr = samp ? MP + ((row - MP) >> 6) * SKV + PAST + ((row - MP) & 63) : row;
                        *(u32x4*)((bf16_t*)(ws + WS_KIX) + (size_t)kvr * 64 + colw) = pack8bf(v0, v1);
                        float* o = out + (samp ? O_SIDX + (size_t)(row - MP) * 64 : O_PIDX + (size_t)row * 64) + colw;
                        *(f32x4*)o = v0; *(f32x4*)(o + 4) = v1;
                    } else { float* o = (float*)(ws + WS_WIX) + (size_t)row * 16 + (colw - 64); *(f32x4*)o = v0; *(f32x4*)(o + 4) = v1; } }
            return;
        }
        const int seg = pn >> 2, cseg = (pn & 3) * 256 + colw;
        if (seg == 0 || seg == 3 || seg == 6) {
            bf16_t* Q = (bf16_t*)(ws + WS_QSB + (size_t)(seg / 3) * (68 * MiB)) + cseg;
#pragma unroll
            for (int ai = 0; ai < 2; ++ai)
#pragma unroll
                for (int m = 0; m < 4; ++m) { bf16_t* rowp = Q + (size_t)(row0 + ai * HALF + m * 16) * 1024;
#pragma unroll
                    for (int bj = 0; bj < 2; ++bj) { const u32x4 w8 = pack8bf(acc[ai][bj][m][0], acc[ai][bj][m][1]); if (seg == 3) __builtin_nontemporal_store(w8, (u32x4*)(rowp + bj * HALF)); else *(u32x4*)(rowp + bj * HALF) = w8; } }
            return;
        }
        const int j = seg < 3 ? seg - 1 : seg - 2;
        bf16_t* KV = (bf16_t*)(ws + WS_KSB + (size_t)j * (196 * MiB)) + cseg;
        float* OF = out + (samp ? O_SSBK + (size_t)j * 2097152 : O_PSBK + (size_t)j * 33554432) + cseg;
#pragma unroll
        for (int ai = 0; ai < 2; ++ai)
#pragma unroll
            for (int m = 0; m < 4; ++m) { const int row = row0 + ai * HALF + m * 16;
                const int kvr = samp ? MP + ((row - MP) >> 6) * SKV + PAST + ((row - MP) & 63) : row;
                bf16_t* rowb = KV + (size_t)kvr * 1024; float* rowf = OF + (size_t)(samp ? row - MP : row) * 1024;
#pragma unroll
                for (int bj = 0; bj < 2; ++bj) { const f32x4 v0 = acc[ai][bj][m][0], v1 = acc[ai][bj][m][1];
                    if (j >= 2) __builtin_nontemporal_store(pack8bf(v0, v1), (u32x4*)(rowb + bj * HALF)); else *(u32x4*)(rowb + bj * HALF) = pack8bf(v0, v1); __builtin_nontemporal_store(v0, (f32x4*)(rowf + bj * HALF)); __builtin_nontemporal_store(v1, (f32x4*)(rowf + bj * HALF + 4)); } }
    }
};
struct EpiBr1 {
    static constexpr bool PERM = true, AFTER_DRAIN = false;
    unsigned char* ws;
    __device__ __forceinline__ void operator()(const f32x4 (&acc)[2][2][4][2], const Unit& u, int wr, int wc, int fr, int fq) const {
        const int col0 = u.pn * BM + wc * 32 + 8 * fq, row0 = u.pm * BM + wr * 64 + fr;
#pragma unroll
        for (int ai = 0; ai < 2; ++ai)
#pragma unroll
            for (int m = 0; m < 4; ++m) { const size_t row = (size_t)(row0 + ai * HALF + m * 16);
                const bf16_t* g = (const bf16_t*)(ws + WS_G) + row * 4096 + col0; bf16_t* t = (bf16_t*)(ws + WS_TMP) + row * 2048 + col0;
#pragma unroll
                for (int bj = 0; bj < 2; ++bj) { f32x4 g0, g1; unpack8bf(*(const u32x4*)(g + bj * HALF), g0, g1);
                    *(u32x4*)(t + bj * HALF) = pack8bf(acc[ai][bj][m][0] * g0, acc[ai][bj][m][1] * g1); } }
    }
};
struct EpiBr2 {
    static constexpr bool PERM = true, AFTER_DRAIN = false;
    unsigned char* ws;
    __device__ __forceinline__ void operator()(const f32x4 (&acc)[2][2][4][2], const Unit& u, int wr, int wc, int fr, int fq) const {
        const int col0 = u.pn * BM + wc * 32 + 8 * fq, row0 = u.pm * BM + wr * 64 + fr;
#pragma unroll
        for (int ai = 0; ai < 2; ++ai)
#pragma unroll
            for (int m = 0; m < 4; ++m) { const size_t row = (size_t)(row0 + ai * HALF + m * 16);
                const bf16_t* g = (const bf16_t*)(ws + WS_G) + row * 4096 + 2048 + col0; const bf16_t* t = (const bf16_t*)(ws + WS_TMP) + row * 2048 + col0;
                bf16_t* o = (bf16_t*)(ws + WS_MRG) + row * 2048 + col0;
#pragma unroll
                for (int bj = 0; bj < 2; ++bj) { f32x4 g0, g1, t0, t1; unpack8bf(*(const u32x4*)(g + bj * HALF), g0, g1); unpack8bf(*(const u32x4*)(t + bj * HALF), t0, t1);
                    const f32x4 v0 = t0 + acc[ai][bj][m][0] * g0, v1 = t1 + acc[ai][bj][m][1] * g1;
                    *(u32x4*)(o + bj * HALF) = pack8bf(v0, v1); } }
    }
};
struct EpiRes {
    static constexpr bool PERM = true, AFTER_DRAIN = false;
    const float* base_p; const float* base_s; float* dst; const float* mod; int gchunk;
    __device__ __forceinline__ void operator()(const f32x4 (&acc)[2][2][4][2], const Unit& u, int wr, int wc, int fr, int fq) const {
        const int col0 = u.pn * BM + wc * 32 + 8 * fq, row0 = u.pm * BM + wr * 64 + fr;
#pragma unroll
        for (int ai = 0; ai < 2; ++ai) {
            const int rowa = row0 + ai * HALF;
            const float* gt = mod + (size_t)(rowa < MP ? (rowa >> 14) : 2 + ((rowa - MP) >> 6)) * 12288 + gchunk * 2048 + col0;
            const f32x4 g00 = *(const f32x4*)(gt), g01 = *(const f32x4*)(gt + 4), g10 = *(const f32x4*)(gt + HALF), g11 = *(const f32x4*)(gt + HALF + 4);
#pragma unroll
            for (int m = 0; m < 4; ++m) { const int row = rowa + m * 16;
                const float* b = (row < MP ? base_p + (size_t)row * 2048 : base_s + (size_t)(row - MP) * 2048) + col0;
                float* o = dst + (size_t)row * 2048 + col0;
                *(f32x4*)(o) = *(const f32x4*)(b) + g00 * acc[ai][0][m][0];
                *(f32x4*)(o + 4) = *(const f32x4*)(b + 4) + g01 * acc[ai][0][m][1];
                *(f32x4*)(o + HALF) = *(const f32x4*)(b + HALF) + g10 * acc[ai][1][m][0];
                *(f32x4*)(o + HALF + 4) = *(const f32x4*)(b + HALF + 4) + g11 * acc[ai][1][m][1]; } }
    }
};
#define PG8_DPP_ROR(x, n) __builtin_bit_cast(float, __builtin_amdgcn_update_dpp(0, __builtin_bit_cast(int, (x)), 0x120 + (n), 0xf, 0xf, false))
struct EpiUpConv {
    static constexpr bool PERM = true, AFTER_DRAIN = false;
    unsigned char* ws; float* out; const float* cw; const float* cb; const float* st; PG8_LAS float* halo;
    __device__ __forceinline__ void operator()(const f32x4 (&acc)[2][2][4][2], const Unit& u, int wr, int wc, int fr, int fq) const {
        const int pn = u.pn, pm = u.pm; const bool samp = pm >= 128;
        const int colw = wc * 32 + 8 * fq, ch0 = pn * 128 + colw, row0 = pm * BM + wr * 64 + fr;
        if (fr >= 14) {
#pragma unroll
            for (int ai = 0; ai < 2; ++ai) { PG8_LAS float* h = halo + ((ai * 2 + wr) * 2 + (fr - 14)) * 128 + colw;
                *(PG8_LAS f32x4*)h = acc[ai][0][3][0]; *(PG8_LAS f32x4*)(h + 4) = acc[ai][0][3][1]; } }
        asm volatile("s_waitcnt lgkmcnt(0)" ::: "memory"); __builtin_amdgcn_s_barrier(); asm volatile("" ::: "memory");
        float w0[8], w1[8], w2[8], bb[8];
#pragma unroll
        for (int j = 0; j < 8; ++j) { w0[j] = cw[ch0 + j]; w1[j] = cw[DFF + ch0 + j]; w2[j] = cw[2 * DFF + ch0 + j]; bb[j] = cb[ch0 + j]; }
#pragma unroll
        for (int ai = 0; ai < 2; ++ai) {
            float e1[8], e2[8];
            const int grow0 = pm * BM + ai * HALF + wr * 64;
            bool defer = false;
            if (samp) { const float* s0 = st + (size_t)((grow0 - MP) >> 6) * 2 * DFF + ch0;
#pragma unroll
                for (int j = 0; j < 8; ++j) { e2[j] = s0[j]; e1[j] = s0[DFF + j]; } }
            else if (ai == 0 && wr == 0) { defer = (pm & 63) != 0;
#pragma unroll
                for (int j = 0; j < 8; ++j) { e2[j] = 0.f; e1[j] = 0.f; } }
            else { const int pg = ai * 2 + wr - 1; const PG8_LAS float* h = halo + (pg * 2) * 128 + colw;
                const f32x4 a0 = *(const PG8_LAS f32x4*)h, a1 = *(const PG8_LAS f32x4*)(h + 4), b0 = *(const PG8_LAS f32x4*)(h + 128), b1 = *(const PG8_LAS f32x4*)(h + 132);
#pragma unroll
                for (int j = 0; j < 4; ++j) { e2[j] = a0[j]; e2[4 + j] = a1[j]; e1[j] = b0[j]; e1[4 + j] = b1[j]; } }
            float pr1[8], pr2[8];
#pragma unroll
            for (int j = 0; j < 8; ++j) { pr1[j] = e1[j]; pr2[j] = fr == 0 ? e2[j] : e1[j]; }
#pragma unroll
            for (int m = 0; m < 4; ++m) { const int row = row0 + ai * HALF + m * 16;
                float g[8], v[8], o[8];
#pragma unroll
                for (int j = 0; j < 4; ++j) { g[j] = acc[ai][0][m][0][j]; g[4 + j] = acc[ai][0][m][1][j]; v[j] = acc[ai][1][m][0][j]; v[4 + j] = acc[ai][1][m][1][j]; }
#pragma unroll
                for (int j = 0; j < 8; ++j) { const float r1 = PG8_DPP_ROR(g[j], 1), r2 = PG8_DPP_ROR(g[j], 2);
                    const float p1 = fr == 0 ? pr1[j] : r1;
                    const float p2 = fr <= 1 ? pr2[j] : r2;
                    const float cv = bb[j] + w0[j] * p2 + w1[j] * p1 + w2[j] * g[j];
                    o[j] = cv * sigm(cv) * v[j];
                    pr1[j] = r1; pr2[j] = r2; }
                if (!(defer && m == 0 && fr < 2)) { bf16_t* op = (bf16_t*)(ws + WS_ACT) + (size_t)row * DFF + ch0; __builtin_nontemporal_store(pack8bf((f32x4){o[0], o[1], o[2], o[3]}, (f32x4){o[4], o[5], o[6], o[7]}), (u32x4*)op); }
                if (m == 0 && fr < 2 && defer) { float* hp = (float*)(ws + WS_HEAD) + (((size_t)pm * 44 + pn) * 4 + fr) * 128 + colw;
#pragma unroll
                    for (int j = 0; j < 8; ++j) { hp[j] = g[j]; hp[256 + j] = v[j]; } }
                if (m == 3 && fr >= 14) {
                    if (!samp && ai == 1 && wr == 1) { float* tp = (float*)(ws + WS_TAIL) + (((size_t)pm * 44 + pn) * 2 + (fr - 14)) * 128 + colw;
#pragma unroll
                        for (int j = 0; j < 8; ++j) tp[j] = g[j]; }
                    float* so = nullptr;
                    if (!samp) { if (ai == 1 && wr == 1 && (pm & 63) == 63) so = out + O_PCONV + (size_t)((pm >> 6) * 2 + (fr - 14)) * DFF; }
                    else so = out + O_SCONV + (size_t)(((row - MP) >> 6) * 2 + (fr - 14)) * DFF;
                    if (so) {
#pragma unroll
                        for (int j = 0; j < 8; ++j) so[ch0 + j] = g[j]; } } }
        }
        asm volatile("s_waitcnt lgkmcnt(0)" ::: "memory"); __builtin_amdgcn_s_barrier(); asm volatile("" ::: "memory");
    }
};
template <class Epi, class Sched, bool ALIGN_EPI = false, bool SP2 = false>
__device__ __forceinline__ void gemm_phase(PG8_LAS unsigned char* lds, const Gemm g, const Sched& S, const Epi& E) {
    const int tid = threadIdx.x, wid = __builtin_amdgcn_readfirstlane(tid >> 6), lane = tid & 63, wr = wid >> 2, wc = wid & 3, fr = lane & 15, fq = lane >> 4;
    const int K = g.K, nt = K / BK;
    unsigned voffA[2], voffB[2];
#pragma unroll
    for (int i = 0; i < 2; ++i) { int R, C; stage_rc(tid * 16 + i * 8192, R, C); const int Rb = Epi::PERM ? ((R & ~31) + perm32(R & 31)) : R;
        voffA[i] = (unsigned)(R * K + C) * 2u; voffB[i] = (unsigned)(Rb * K + C) * 2u; }
    const size_t kstep = (size_t)(BK * 2);
    const size_t hstep = (size_t)HALF * K * 2;
    const size_t tstep = 2 * hstep;
    const unsigned ldsw = (unsigned)wid * 1024u;
    const int aoff = lds_byte(wr * 64 + fr, fq * 8), boff = lds_byte(wc * 32 + fr, fq * 8);
#define PG8_SA(b, h) (((b) * 2 + (h)) * HTB)
#define PG8_SB(b, h) ((4 + (b) * 2 + (h)) * HTB)
#define PG8_STAGE(bufoff, gbase, voff) do { _Pragma("unroll") for (int _i = 0; _i < 2; ++_i) \
        __builtin_amdgcn_global_load_lds((const unsigned*)((const char*)(gbase) + (voff)[_i]), (PG8_LAS unsigned*)(lds + (bufoff) + ldsw + _i * 8192), 16, 0, 0); } while (0)
#define PG8_LDA(dst, b, h) do { _Pragma("unroll") for (int m = 0; m < 4; ++m) _Pragma("unroll") for (int k = 0; k < 2; ++k) dst[m][k] = *(const PG8_LAS bf16x8*)(lds + PG8_SA(b, h) + aoff + m * 2048 + k * 1024); } while (0)
#define PG8_LDB(dst, b, h) do { _Pragma("unroll") for (int n = 0; n < 2; ++n) _Pragma("unroll") for (int k = 0; k < 2; ++k) dst[n][k] = *(const PG8_LAS bf16x8*)(lds + PG8_SB(b, h) + boff + n * 2048 + k * 1024); } while (0)
#define PG8_MMA(ai, bj, At, Bt) do { __builtin_amdgcn_s_setprio(1); _Pragma("unroll") for (int m = 0; m < 4; ++m) _Pragma("unroll") for (int n = 0; n < 2; ++n) _Pragma("unroll") for (int k = 0; k < 2; ++k) \
        acc[ai][bj][m][n] = __builtin_amdgcn_mfma_f32_16x16x32_bf16(Bt[n][k], At[m][k], acc[ai][bj][m][n], 0, 0, 0); __builtin_amdgcn_s_setprio(0); } while (0)
#define PG8_WAIT_V(n) asm volatile("s_waitcnt vmcnt(" #n ")" ::: "memory")
#define PG8_WAIT_L(n) asm volatile("s_waitcnt lgkmcnt(" #n ")" ::: "memory")
#define PG8_BAR __builtin_amdgcn_s_barrier()
#define PG8_SCHED __builtin_amdgcn_sched_barrier(0)
    Unit cur, nxt; int ui = 0;
    if (!S.next(0, cur)) return;
    f32x4 acc[2][2][4][2];
#pragma unroll
    for (int a = 0; a < 2; ++a)
#pragma unroll
        for (int b = 0; b < 2; ++b)
#pragma unroll
            for (int m = 0; m < 4; ++m)
#pragma unroll
                for (int n = 0; n < 2; ++n) acc[a][b][m][n] = (f32x4){0.f, 0.f, 0.f, 0.f};
    bf16x8 At[4][2], B0[2][2], B1[2][2];
    const char* cA = (const char*)g.A + (size_t)cur.pm * tstep; const char* cB = (const char*)g.Bt + (size_t)cur.pn * tstep;
    S.a_ready(cur);
    if constexpr (SP2) {
        PG8_STAGE(PG8_SB(0, 0), cB, voffB); PG8_STAGE(PG8_SB(0, 1), cB + hstep, voffB); PG8_STAGE(PG8_SA(0, 0), cA, voffA); PG8_STAGE(PG8_SA(0, 1), cA + hstep, voffA);
        if (wr == 1) PG8_BAR;
        PG8_WAIT_V(2); PG8_BAR;
        PG8_STAGE(PG8_SB(1, 0), cB + kstep, voffB); PG8_STAGE(PG8_SA(1, 0), cA + kstep, voffA); PG8_STAGE(PG8_SB(1, 1), cB + hstep + kstep, voffB);
        PG8_WAIT_V(6); PG8_BAR;
    } else {
        PG8_STAGE(PG8_SB(0, 0), cB, voffB); PG8_STAGE(PG8_SA(0, 0), cA, voffA); PG8_STAGE(PG8_SB(0, 1), cB + hstep, voffB); PG8_STAGE(PG8_SA(0, 1), cA + hstep, voffA);
        if (wr == 1) PG8_BAR;
        PG8_WAIT_V(4); PG8_BAR;
        PG8_STAGE(PG8_SB(1, 0), cB + kstep, voffB); PG8_STAGE(PG8_SA(1, 0), cA + kstep, voffA); PG8_STAGE(PG8_SB(1, 1), cB + hstep + kstep, voffB);
        PG8_WAIT_V(6); PG8_BAR;
    }
    for (;;) {
        const bool has_next = S.next(ui + 1, nxt);
        const char* nA = has_next ? (const char*)g.A + (size_t)nxt.pm * tstep : cA; const char* nB = has_next ? (const char*)g.Bt + (size_t)nxt.pn * tstep : cB;
        for (int t = 0; t < nt; t += 2) {
            const bool last = (t == nt - 2);
            const char* a1 = cA + (size_t)(t + 1) * kstep;
            const char* a2 = last ? nA : cA + (size_t)(t + 2) * kstep; const char* b2 = last ? nB : cB + (size_t)(t + 2) * kstep;
            const char* a3 = a2 + kstep; const char* b3 = b2 + kstep;
            if (last && has_next) S.a_ready(nxt);
            if constexpr (SP2) {
            PG8_LDB(B0, 0, 0); PG8_LDB(B1, 0, 1); PG8_SCHED; PG8_LDA(At, 0, 0); PG8_STAGE(PG8_SA(1, 1), a1 + hstep, voffA);
            PG8_WAIT_V(8); PG8_WAIT_L(0); PG8_BAR; PG8_MMA(0, 0, At, B0); PG8_MMA(0, 1, At, B1); PG8_BAR; PG8_SCHED;
            PG8_LDA(At, 0, 1); PG8_STAGE(PG8_SB(0, 0), b2, voffB); PG8_STAGE(PG8_SB(0, 1), b2 + hstep, voffB); PG8_STAGE(PG8_SA(0, 0), a2, voffA);
            PG8_WAIT_V(8); PG8_WAIT_L(0); PG8_BAR; PG8_MMA(1, 0, At, B0); PG8_MMA(1, 1, At, B1); PG8_BAR; PG8_SCHED;
            PG8_LDB(B0, 1, 0); PG8_LDB(B1, 1, 1); PG8_SCHED; PG8_LDA(At, 1, 0); PG8_STAGE(PG8_SA(0, 1), a2 + hstep, voffA);
            PG8_WAIT_V(8); PG8_WAIT_L(0); PG8_BAR; PG8_MMA(0, 0, At, B0); PG8_MMA(0, 1, At, B1); PG8_BAR; PG8_SCHED;
            PG8_LDA(At, 1, 1); PG8_STAGE(PG8_SB(1, 0), b3, voffB); PG8_STAGE(PG8_SB(1, 1), b3 + hstep, voffB); PG8_STAGE(PG8_SA(1, 0), a3, voffA);
            PG8_WAIT_V(8); PG8_WAIT_L(0); PG8_BAR; PG8_MMA(1, 0, At, B0); PG8_MMA(1, 1, At, B1); PG8_BAR; PG8_SCHED;
            } else {
            PG8_LDB(B0, 0, 0); PG8_SCHED; PG8_LDA(At, 0, 0); PG8_STAGE(PG8_SA(1, 1), a1 + hstep, voffA);
            PG8_WAIT_L(8); PG8_BAR; PG8_WAIT_L(0); PG8_MMA(0, 0, At, B0); PG8_BAR; PG8_SCHED;
            PG8_LDB(B1, 0, 1); PG8_STAGE(PG8_SB(0, 0), b2, voffB);
            PG8_BAR; PG8_WAIT_L(0); PG8_MMA(0, 1, At, B1); PG8_BAR;
            PG8_LDA(At, 0, 1); PG8_STAGE(PG8_SA(0, 0), a2, voffA);
            PG8_BAR; PG8_WAIT_L(0); PG8_MMA(1, 0, At, B0); PG8_BAR; PG8_SCHED;
            PG8_STAGE(PG8_SB(0, 1), b2 + hstep, voffB);
            PG8_WAIT_V(6); PG8_BAR; PG8_MMA(1, 1, At, B1); PG8_BAR;
            PG8_LDB(B0, 1, 0); PG8_SCHED; PG8_LDA(At, 1, 0); PG8_STAGE(PG8_SA(0, 1), a2 + hstep, voffA);
            PG8_WAIT_L(8); PG8_BAR; PG8_WAIT_L(0); PG8_MMA(0, 0, At, B0); PG8_BAR; PG8_SCHED;
            PG8_LDB(B1, 1, 1); PG8_STAGE(PG8_SB(1, 0), b3, voffB);
            PG8_BAR; PG8_WAIT_L(0); PG8_MMA(0, 1, At, B1); PG8_BAR;
            PG8_LDA(At, 1, 1); PG8_STAGE(PG8_SA(1, 0), a3, voffA);
            PG8_BAR; PG8_WAIT_L(0); PG8_MMA(1, 0, At, B0); PG8_BAR; PG8_SCHED;
            PG8_STAGE(PG8_SB(1, 1), b3 + hstep, voffB);
            PG8_WAIT_V(6); PG8_BAR; PG8_MMA(1, 1, At, B1); PG8_BAR;
            }
        }
        if constexpr (ALIGN_EPI) { if (wr == 0) PG8_BAR; }
        if constexpr (!Epi::AFTER_DRAIN) { E(acc, cur, wr, wc, fr, fq); S.done(cur); }
        if (!has_next) break;
#pragma unroll
        for (int a = 0; a < 2; ++a)
#pragma unroll
            for (int b = 0; b < 2; ++b)
#pragma unroll
                for (int m = 0; m < 4; ++m)
#pragma unroll
                    for (int n = 0; n < 2; ++n) acc[a][b][m][n] = (f32x4){0.f, 0.f, 0.f, 0.f};
        cur = nxt; cA = nA; cB = nB; ++ui;
        if constexpr (ALIGN_EPI) { if (wr == 1) PG8_BAR; }
    }
    PG8_WAIT_V(0);
    if constexpr (!ALIGN_EPI) { if (wr == 0) PG8_BAR; }
    PG8_BAR;
    if constexpr (Epi::AFTER_DRAIN) { E.fused(acc, cur, wr, wc, fr, fq, lds, wid, lane); S.done(cur); }
#undef PG8_SA
#undef PG8_SB
#undef PG8_STAGE
#undef PG8_LDA
#undef PG8_LDB
#undef PG8_MMA
#undef PG8_WAIT_V
#undef PG8_WAIT_L
#undef PG8_BAR
#undef PG8_SCHED
}
}
#define XB_TMO      128
#define XB_XCNT(j)  (256  + 64 * (j))
#define XB_XSUB(j)  (1280 + 64 * (j))
#define XB_XGEN(j)  (2304 + 64 * (j))
#define XB_TOP      3328
#define XB_TOPGEN   3392
#define XCD_BAR_WORDS 3456
#define XB_SPIN_CAP (1u << 18)
#define LAS __attribute__((address_space(3)))

__device__ __forceinline__ unsigned xb_ld(unsigned* p)              { return __hip_atomic_load(p, __ATOMIC_RELAXED, __HIP_MEMORY_SCOPE_AGENT); }
__device__ __forceinline__ unsigned xb_add(unsigned* p, unsigned v) { return __hip_atomic_fetch_add(p, v, __ATOMIC_RELAXED, __HIP_MEMORY_SCOPE_AGENT); }
__device__ __forceinline__ unsigned xb_xcc_id() { return (unsigned)__builtin_amdgcn_s_getreg((3 << 11) | 20) & 0xFu; }
#define XB_SPIN(cond, bar) do { unsigned _sp = 0; while (cond) { __builtin_amdgcn_s_sleep(1); \
    if ((++_sp & 255u) == 0u) { if (xb_ld(&(bar)[XB_TMO])) break; if (_sp > XB_SPIN_CAP) { atomicAdd(&(bar)[XB_TMO], 1u); break; } } } } while (0)

struct XcdBarrier {
    unsigned* bar; unsigned x;
    volatile LAS unsigned* st;
};

__device__ __forceinline__ XcdBarrier xcd_barrier_post(unsigned* bar, volatile LAS unsigned* st) {
    XcdBarrier b; b.bar = bar; b.x = xb_xcc_id(); b.st = st;
    if (threadIdx.x == 0) (void)xb_add(&bar[XB_XCNT(b.x)], 1u);
    return b;
}
__device__ __forceinline__ void xcd_barrier_complete(unsigned* bar, unsigned x, unsigned& nloc, unsigned& nx) {
    const unsigned G = gridDim.x * gridDim.y * gridDim.z;
    unsigned sum, cnt, mine, sp = 0u;
    for (;;) {
        sum = 0u; cnt = 0u; mine = 0u;
#pragma unroll
        for (unsigned j = 0; j < 16; ++j) { const unsigned c = xb_ld(&bar[XB_XCNT(j)]); sum += c; cnt += (c > 0u) ? 1u : 0u; mine = (j == x) ? c : mine; }
        if (sum == G) break;
        __builtin_amdgcn_s_sleep(1);
        if ((++sp & 255u) == 0u) { if (xb_ld(&bar[XB_TMO])) break; if (sp > XB_SPIN_CAP) { atomicAdd(&bar[XB_TMO], 1u); break; } }
    }
    nloc = mine > 0u ? mine : 1u; nx = cnt > 0u ? cnt : 1u;
}

__device__ __forceinline__ void xcd_barrier(const XcdBarrier& b) {
    asm volatile("s_waitcnt vmcnt(0)" ::: "memory");
    __syncthreads();
    if (threadIdx.x == 0) {
        unsigned* bar = b.bar;
        __builtin_amdgcn_s_waitcnt(0);
        unsigned nloc = b.st[0], nx = b.st[1];
        if (nloc == 0u) { xcd_barrier_complete(bar, b.x, nloc, nx); b.st[0] = nloc; b.st[1] = nx; }
        const unsigned old = xb_add(&bar[XB_XSUB(b.x)], 1u);
        const unsigned gen = old / nloc;
        if (old + 1u == (gen + 1u) * nloc) {
            __builtin_amdgcn_fence(__ATOMIC_RELEASE, "agent");
            asm volatile("s_waitcnt vmcnt(0)" ::: "memory");
            const unsigned og = xb_add(&bar[XB_TOP], 1u);
            const unsigned tg = og / nx;
            if (og + 1u == (tg + 1u) * nx) xb_add(&bar[XB_TOPGEN], 1u);
            else XB_SPIN(xb_ld(&bar[XB_TOPGEN]) == tg, bar);
            __builtin_amdgcn_fence(__ATOMIC_ACQUIRE, "agent");
            xb_add(&bar[XB_XGEN(b.x)], 1u);
            asm volatile("s_waitcnt vmcnt(0)" ::: "memory");
        } else {
            XB_SPIN(xb_ld(&bar[XB_XGEN(b.x)]) == gen, bar);
            __builtin_amdgcn_fence(__ATOMIC_ACQUIRE, "agent");
            asm volatile("s_waitcnt vmcnt(0)" ::: "memory");
        }
    }
    __syncthreads();
}
__device__ __forceinline__ void xcd_count_in(const XcdBarrier& b, unsigned* loc, unsigned* glob) {
    const unsigned nloc = b.st[0];
    const unsigned old = xb_add(loc + 64 * b.x, 1u);
    if (old + 1u == nloc) { __builtin_amdgcn_fence(__ATOMIC_RELEASE, "agent"); asm volatile("s_waitcnt vmcnt(0)" ::: "memory"); (void)xb_add(glob, nloc); }
}
constexpr int NWAVES = 8;
struct Frame {
    LAS unsigned char* lds;
    unsigned char* ws; float* out;
    int tid, lane, wave, G, c;
    const float* in[25];
};
enum { I_XP = 0, I_XS, I_CSBK, I_CSBV, I_CSAK, I_CSAV, I_CIDX, I_CONVST, I_CP, I_CS, I_WADA, I_BADA, I_GMIX, I_WIN, I_WGATE, I_WBRSB, I_WBRSA, I_WOUT, I_REL, I_GFFN, I_WUP, I_CONVW, I_CONVB, I_WDOWN, I_GFINAL };

__device__ __forceinline__ void p0_transpose_item(const float* W, int K, int N, bf16* WT, int row_off, LAS float* scr, int item, int lane) {
    const int nblk = (N + 31) / 32, kb = item / nblk, nb = item % nblk, k0 = 64 * kb, n0 = 32 * nb;
    const int cg = 4 * (lane & 7); const bool cok = (n0 + cg) < N;
    f32x4 tv[8];
#pragma unroll
    for (int i = 0; i < 8; ++i) { const int kk = 8 * i + (lane >> 3); tv[i] = cok ? *(const GAS f32x4*)(W + (size_t)(k0 + kk) * N + n0 + cg) : (f32x4){0.f, 0.f, 0.f, 0.f}; }
#pragma unroll
    for (int i = 0; i < 8; ++i) { LAS float* d = scr + (8 * i + (lane >> 3)) * 33 + cg; d[0] = tv[i][0]; d[1] = tv[i][1]; d[2] = tv[i][2]; d[3] = tv[i][3]; }
    LDS_WAIT(); asm volatile("" ::: "memory");
    const int c = lane & 7;
#pragma unroll
    for (int j = 0; j < 4; ++j) { const int n = (lane >> 3) + 8 * j; const LAS float* s = scr + (8 * c) * 33 + n;
        v4u o; o.x = pk2(s[0 * 33], s[1 * 33]); o.y = pk2(s[2 * 33], s[3 * 33]); o.z = pk2(s[4 * 33], s[5 * 33]); o.w = pk2(s[6 * 33], s[7 * 33]);
        if (n0 + n < N) *(GAS v4u*)(WT + (size_t)(row_off + n0 + n) * K + k0 + 8 * c) = o; }
    LDS_WAIT(); asm volatile("" ::: "memory");
}
__device__ __forceinline__ void p0_mod(Frame& F, int blk) {
    const float* wada = F.in[I_WADA]; const int l15 = F.lane & 15, l4 = F.lane >> 4;
    f32x4 acc[3][4];
#pragma unroll
    for (int rb = 0; rb < 3; ++rb)
#pragma unroll
        for (int cb = 0; cb < 4; ++cb) acc[rb][cb] = (f32x4){0.f, 0.f, 0.f, 0.f};
    const int kw = F.wave * 256 + l4;
    const float* a0 = F.in[I_CP] + (size_t)(l15 < 2 ? l15 : 0) * DM + kw;
    const float* a0s = F.in[I_CS] + (size_t)(l15 < 2 ? 0 : l15 - 2) * DM + kw;
    const float* a1 = F.in[I_CS] + (size_t)(14 + l15) * DM + kw;
    const float* a2 = F.in[I_CS] + (size_t)(l15 < 2 ? 30 + l15 : 30) * DM + kw;
    const float* bp = wada + (size_t)kw * 12288 + blk * 64 + l15;
#pragma unroll 4
    for (int ks = 0; ks < 64; ++ks) {
        const float c0 = l15 < 2 ? a0[4 * ks] : a0s[4 * ks], c1 = a1[4 * ks], c2 = l15 < 2 ? a2[4 * ks] : 0.f;
        const float s0 = c0 * sigmoidf_(c0), s1 = c1 * sigmoidf_(c1), s2 = c2 * sigmoidf_(c2);
        float bv[4];
#pragma unroll
        for (int cb = 0; cb < 4; ++cb) bv[cb] = bp[(size_t)(4 * ks) * 12288 + 16 * cb];
#pragma unroll
        for (int cb = 0; cb < 4; ++cb) { acc[0][cb] = __builtin_amdgcn_mfma_f32_16x16x4f32(s0, bv[cb], acc[0][cb], 0, 0, 0);
                                         acc[1][cb] = __builtin_amdgcn_mfma_f32_16x16x4f32(s1, bv[cb], acc[1][cb], 0, 0, 0);
                                         acc[2][cb] = __builtin_amdgcn_mfma_f32_16x16x4f32(s2, bv[cb], acc[2][cb], 0, 0, 0); }
    }
    LAS float* red = (LAS float*)(F.lds + RING_OFF);
#pragma unroll
    for (int rb = 0; rb < 3; ++rb)
#pragma unroll
        for (int cb = 0; cb < 4; ++cb)
#pragma unroll
            for (int i = 0; i < 4; ++i) { const int row = 16 * rb + 4 * l4 + i; if (row < 34) red[(F.wave * 34 + row) * 64 + 16 * cb + l15] = acc[rb][cb][i]; }
    __syncthreads();
    float* mod = (float*)(F.ws + WS_MOD);
    for (int o = F.tid; o < 34 * 64; o += NWAVES * 64) { const int b = o >> 6, l = o & 63; float v = F.in[I_BADA][blk * 64 + l];
#pragma unroll
        for (int w = 0; w < 8; ++w) v += red[(w * 34 + b) * 64 + l];
        mod[(size_t)b * 12288 + blk * 64 + l] = v; }
    __syncthreads();
}
__device__ __forceinline__ void p0_prologue(Frame& F) {
    if (F.c < 192) p0_mod(F, F.c);
    LAS float* scr = (LAS float*)(F.lds + RING_OFF + F.wave * 16384);
    const int gw = F.c * NWAVES + F.wave, NGW = F.G * NWAVES;
    constexpr int I0 = 32 * 227, I1 = 32 * 128, I2 = 16 * 64, I3 = 16 * 64, I4 = 32 * 64, I5 = 32 * 352, I6 = 88 * 64;
    constexpr int NITEMS = I0 + I1 + I2 + I3 + I4 + I5 + I6;
    for (int it = gw; it < NITEMS; it += NGW) {
        int r = it;
        if (r < I0) { p0_transpose_item(F.in[I_WIN], 2048, 7248, (bf16*)(F.ws + WS_WCAT), 0, scr, r, F.lane); continue; } r -= I0;
        if (r < I1) { p0_transpose_item(F.in[I_WGATE], 2048, 4096, (bf16*)(F.ws + WS_WCAT), NGATE0, scr, r, F.lane); continue; } r -= I1;
        if (r < I2) { p0_transpose_item(F.in[I_WBRSB], 1024, 2048, (bf16*)(F.ws + WS_WBRSB), 0, scr, r, F.lane); continue; } r -= I2;
        if (r < I3) { p0_transpose_item(F.in[I_WBRSA], 1024, 2048, (bf16*)(F.ws + WS_WBRSA), 0, scr, r, F.lane); continue; } r -= I3;
        if (r < I4) { p0_transpose_item(F.in[I_WOUT], 2048, 2048, (bf16*)(F.ws + WS_WOUT), 0, scr, r, F.lane); continue; } r -= I4;
        if (r < I5) { const int n0 = 32 * (r % 352), bj = n0 / DFF, ch = n0 % DFF;
            p0_transpose_item(F.in[I_WUP], 2048, NUP, (bf16*)(F.ws + WS_WUP), 256 * (ch >> 7) + 128 * bj + (ch & 127) - n0, scr, r, F.lane); continue; } r -= I5;
        p0_transpose_item(F.in[I_WDOWN], DFF, 2048, (bf16*)(F.ws + WS_WDOWN), 0, scr, r, F.lane);
    }
    const size_t gt = (size_t)F.c * (NWAVES * 64) + F.tid, NGT = (size_t)F.G * NWAVES * 64;
    for (size_t i = gt; i < 45056; i += NGT) *(GAS v4u*)((bf16*)(F.ws + WS_WCAT) + (size_t)7248 * 2048 + i * 8) = (v4u){0u, 0u, 0u, 0u};
    { const float* src = F.in[I_CIDX]; bf16* dst = (bf16*)(F.ws + WS_KIX);
        for (size_t i = gt; i < (size_t)524288; i += NGT) { const size_t e = i * 8, s = e >> 17, rem = e & 131071;
            const f32x4 a = *(const GAS f32x4*)(src + e), b = *(const GAS f32x4*)(src + e + 4);
            v4u o; o.x = pk2(a[0], a[1]); o.y = pk2(a[2], a[3]); o.z = pk2(b[0], b[1]); o.w = pk2(b[2], b[3]);
            *(GAS v4u*)(dst + ((size_t)MP + s * SKV) * 64 + rem) = o; } }
}
__device__ __forceinline__ void norm_mod_rows(Frame& F, const float* xp, const float* xs, const float* g, int shchunk, int scchunk, int row0, int row1, int widx, int nw) {
    const int gw = widx * NWAVES + F.wave, NGW = nw * NWAVES; const float* mod = (const float*)(F.ws + WS_MOD);
    f32x4 gj[8], scj[8], shj[8]; int cur = -1;
#pragma unroll
    for (int j = 0; j < 8; ++j) gj[j] = *(const f32x4*)(g + 4 * (F.lane + 64 * j));
    for (int row = row0 + gw; row < row1; row += NGW) {
        const GAS f32x4* xr = (const GAS f32x4*)(row < MP ? xp + (size_t)row * DM : xs + (size_t)(row - MP) * DM) + F.lane;
        f32x4 v[8]; float ss = 0.f;
#pragma unroll
        for (int j = 0; j < 8; ++j) { v[j] = xr[64 * j]; ss += (v[j].x * v[j].x + v[j].y * v[j].y) + (v[j].z * v[j].z + v[j].w * v[j].w); }
        const int mrow = mod_row(row);
        if (mrow != cur) { cur = mrow; const float* mr = mod + (size_t)mrow * 12288;
#pragma unroll
            for (int j = 0; j < 8; ++j) { const int col = 4 * (F.lane + 64 * j); shj[j] = *(const f32x4*)(mr + shchunk * 2048 + col); scj[j] = *(const f32x4*)(mr + scchunk * 2048 + col) + 1.f; } }
        const float rstd = 1.f / sqrtf(wave_sum(ss) * (1.f / DM) + EPS);
        GAS v2u* o8 = (GAS v2u*)((bf16*)(F.ws + WS_HB) + (size_t)row * DM) + F.lane;
#pragma unroll
        for (int j = 0; j < 8; ++j) {
            const f32x4 y = (v[j] * rstd) * gj[j] * scj[j] + shj[j];
            v2u w; w.x = pk2(y[0], y[1]); w.y = pk2(y[2], y[3]); o8[64 * j] = w; }
    }
}
__device__ __forceinline__ void final_norm_rows(Frame& F, int row0, int row1, int widx, int nw) {
    const int gw = widx * NWAVES + F.wave, NGW = nw * NWAVES; const float* g = F.in[I_GFINAL];
    f32x4 gj[8];
#pragma unroll
    for (int j = 0; j < 8; ++j) gj[j] = *(const f32x4*)(g + 4 * (F.lane + 64 * j));
    for (int row = row0 + gw; row < row1; row += NGW) {
        GAS f32x4* xr = (GAS f32x4*)(F.out + O_Y + (size_t)row * DM) + F.lane;
        f32x4 v[8]; float ss = 0.f;
#pragma unroll
        for (int j = 0; j < 8; ++j) { v[j] = xr[64 * j]; ss += (v[j].x * v[j].x + v[j].y * v[j].y) + (v[j].z * v[j].z + v[j].w * v[j].w); }
        const float rstd = 1.f / sqrtf(wave_sum(ss) * (1.f / DM) + EPS);
#pragma unroll
        for (int j = 0; j < 8; ++j) xr[64 * j] = (v[j] * rstd) * gj[j];
    }
}
__device__ __forceinline__ void conv_fix(Frame& F) {
    const size_t gt = (size_t)F.c * (NWAVES * 64) + F.tid, NGT = (size_t)F.G * NWAVES * 64;
    const float* cw = F.in[I_CONVW]; const float* cb = F.in[I_CONVB];
    const float* TAIL = (const float*)(F.ws + WS_TAIL); const float* HEAD = (const float*)(F.ws + WS_HEAD); bf16* A = (bf16*)(F.ws + WS_ACT);
    for (size_t it = gt; it < (size_t)128 * 44 * 128; it += NGT) {
        const int c = (int)(it & 127), pn = (int)((it >> 7) % 44), pm = (int)((it >> 7) / 44);
        if ((pm & 63) == 0) continue;
        const int ch = pn * 128 + c;
        const float* t = TAIL + ((size_t)(pm - 1) * 44 + pn) * 2 * 128 + c; const float* h = HEAD + ((size_t)pm * 44 + pn) * 4 * 128 + c;
        const float t0 = t[0], t1 = t[128], g0 = h[0], g1 = h[128], v0 = h[256], v1 = h[384];
        const float w0 = cw[ch], w1 = cw[DFF + ch], w2 = cw[2 * DFF + ch], b = cb[ch];
        const float c0 = b + w0 * t0 + w1 * t1 + w2 * g0, c1 = b + w0 * t1 + w1 * g0 + w2 * g1;
        A[(size_t)(pm * 256) * DFF + ch] = (bf16)(pk2(c0 * sigmoidf_(c0) * v0, 0.f) & 0xffffu);
        A[(size_t)(pm * 256 + 1) * DFF + ch] = (bf16)(pk2(c1 * sigmoidf_(c1) * v1, 0.f) & 0xffffu);
    }
}
constexpr int AT_K0 = 0, AT_V0 = 32768, AT_FLAGS = 65536, AT_TAB = 65536 + 256;
constexpr int DS_K0 = 0, DS_V0 = 65536, DS_MASK = 131072, DS_TAB = 131072 + 8192, DS_TABN = DS_TAB + 256, DS_TABN_OFF = 653, DS_TABN_N = 720;
#define MFMA32(a, b, c) __builtin_amdgcn_mfma_f32_32x32x16_bf16((a), (b), (c), 0, 0, 0)
struct AttnUnit { int kv_base, q_tok0, q_pos0, nqw, head; const float* ck; const float* cv; };

__device__ __forceinline__ void at_stage(LAS unsigned char* dst, const bf16* src  , int wave, int lane) {
#pragma unroll
    for (int i = 0; i < 2; ++i) { const int piece = i * 8 + wave, row = 4 * piece + (lane >> 4), ch = (lane & 15) ^ (((row & 3) << 2) | ((row >> 2) & 3));
        __builtin_amdgcn_global_load_lds((const unsigned*)((const char*)src + (size_t)row * 2048 + ch * 16), (LAS unsigned*)(dst + piece * 1024), 16, 0, 0); }
}
__device__ __forceinline__ void at_stage_f32(LAS unsigned char* dst, const float* src  , int wave, int lane) {
#pragma unroll
    for (int i = 0; i < 2; ++i) { const int piece = i * 8 + wave, row = 4 * piece + (lane >> 4), ch = (lane & 15) ^ (((row & 3) << 2) | ((row >> 2) & 3));
        const float* g = src + (size_t)row * 1024 + ch * 8; const f32x4 a = *(const GAS f32x4*)g, b = *(const GAS f32x4*)(g + 4);
        v4u o; o.x = pk2(a[0], a[1]); o.y = pk2(a[2], a[3]); o.z = pk2(b[0], b[1]); o.w = pk2(b[2], b[3]);
        *(LAS v4u*)(dst + piece * 1024 + lane * 16) = o; }
}
__device__ __forceinline__ void at_koffs(int lane, int (&ko)[8]) { const int row = lane & 31, hi = lane >> 5, sw = ((row & 3) << 2) | ((row >> 2) & 3);
#pragma unroll
    for (int ks = 0; ks < 8; ++ks) ko[ks] = 256 * row + 16 * ((2 * ks + hi) ^ sw); }
__device__ __forceinline__ void at_voffs(int lane, int (&vo)[4][2]) { const int hi = lane >> 5, q = (lane >> 2) & 3, cl = 2 * ((lane >> 4) & 1) + ((lane & 3) >> 1);
#pragma unroll
    for (int mt = 0; mt < 4; ++mt)
#pragma unroll
        for (int e = 0; e < 2; ++e) { const int row = 4 * hi + q + 8 * e, sw = ((row & 3) << 2) | ((row >> 2) & 3); vo[mt][e] = 256 * row + 16 * ((4 * mt + cl) ^ sw) + 8 * (lane & 1); } }
__device__ __forceinline__ f32x16 at_qk(const LAS unsigned char* kt, const int (&ko)[8], int sub, const bf16x8 (&qf)[8]) {
    f32x16 p;
#pragma unroll
    for (int r = 0; r < 16; ++r) p[r] = 0.f;
#pragma unroll
    for (int ks = 0; ks < 8; ++ks) { const bf16x8 a = *(const LAS bf16x8*)(kt + ko[ks] + sub * 8192); p = MFMA32(a, qf[ks], p); }
    return p;
}
__device__ __forceinline__ void at_pv_w(f32x16 (&o)[4], const LAS unsigned char* vt, const int (&vo)[4][2], int sub, const unsigned (&pw)[8]) {
#pragma unroll
    for (int s = 0; s < 2; ++s) {
        const v4u w = {pw[4 * s], pw[4 * s + 1], pw[4 * s + 2], pw[4 * s + 3]};
        const bf16x8 pb = __builtin_bit_cast(bf16x8, w);
        s16x4 lo[4], hi4[4];
#pragma unroll
        for (int mt = 0; mt < 4; ++mt) { lo[mt] = __builtin_amdgcn_ds_read_tr16_b64_v4i16((LAS s16x4*)(vt + vo[mt][0] + 256 * (16 * s + 32 * sub)));
                                         hi4[mt] = __builtin_amdgcn_ds_read_tr16_b64_v4i16((LAS s16x4*)(vt + vo[mt][1] + 256 * (16 * s + 32 * sub))); }
#pragma unroll
        for (int mt = 0; mt < 4; ++mt) { const bf16x8 va = (bf16x8){lo[mt][0], lo[mt][1], lo[mt][2], lo[mt][3], hi4[mt][0], hi4[mt][1], hi4[mt][2], hi4[mt][3]};
            o[mt] = MFMA32(va, pb, o[mt]); } }
}
__device__ __forceinline__ void at_pv(f32x16 (&o)[4], const LAS unsigned char* vt, const int (&vo)[4][2], int sub, const f32x16& pr) {
    unsigned pw[8];
#pragma unroll
    for (int k = 0; k < 8; ++k) pw[k] = pk2(pr[2 * k], pr[2 * k + 1]);
    at_pv_w(o, vt, vo, sub, pw);
}
__device__ __forceinline__ void at_load_q(bf16x8 (&qf)[8], const bf16* Q, int tok, int head, int lane) {
    int off = tok * 1024 + head * 128 + 8 * (lane >> 5);
    asm volatile("" : "+v"(off));
    const bf16* p = Q + off;
#pragma unroll
    for (int ks = 0; ks < 8; ++ks) qf[ks] = *(const GAS bf16x8*)(p + 16 * ks);
}
__device__ __forceinline__ void at_store_o(const f32x16 (&o)[4], float inv, bf16* O, int tok, int head, int lane) {
    asm volatile("" : "+v"(tok));
    bf16* p = O + (size_t)tok * 1024 + head * 128 + 4 * (lane >> 5);
#pragma unroll
    for (int mt = 0; mt < 4; ++mt)
#pragma unroll
        for (int g = 0; g < 4; ++g) { v2u w; w.x = pk2(o[mt][4 * g] * inv, o[mt][4 * g + 1] * inv); w.y = pk2(o[mt][4 * g + 2] * inv, o[mt][4 * g + 3] * inv);
            *(GAS v2u*)(p + 32 * mt + 8 * g) = w; }
}
__device__ __forceinline__ float xhalf(float v) { return __shfl_xor(v, 32); }

__device__ __forceinline__ void sb_unit(Frame& F, const AttnUnit& U) {
    const bf16* Kb = (const bf16*)(F.ws + WS_KSB) + (size_t)U.kv_base * 1024 + U.head * 128;
    const bf16* Vb = (const bf16*)(F.ws + WS_VSB) + (size_t)U.kv_base * 1024 + U.head * 128;
    bf16* QO = (bf16*)(F.ws + WS_QSB);
    const int lane = F.lane, wave = F.wave, ql = lane & 31, hi = lane >> 5;
    const bool haveq = wave < U.nqw;
    const int tok = U.q_tok0 + 32 * (haveq ? wave : 0) + ql, qpos = U.q_pos0 + 32 * (haveq ? wave : 0) + ql;
    int ko[8], vo[4][2]; at_koffs(lane, ko); at_voffs(lane, vo);
    bf16x8 qf[8]; at_load_q(qf, QO, tok, U.head, lane);
    f32x16 o[4];
#pragma unroll
    for (int mt = 0; mt < 4; ++mt)
#pragma unroll
        for (int r = 0; r < 16; ++r) o[mt][r] = 0.f;
    float carry = 0.f; bool done = !haveq;
    const int T_hi = (U.q_pos0 + 32 * U.nqw - 1) >> 6;
    volatile LAS unsigned* flags = (volatile LAS unsigned*)(F.lds + AT_FLAGS);
#define SB_STAGE(t) do { if (U.ck && 64 * (t) < PAST) { at_stage_f32(F.lds + AT_K0 + ((t) & 1) * 16384, U.ck + (size_t)(t) * 64 * 1024 + U.head * 128, wave, lane); \
                                                          at_stage_f32(F.lds + AT_V0 + ((t) & 1) * 16384, U.cv + (size_t)(t) * 64 * 1024 + U.head * 128, wave, lane); } \
        else { at_stage(F.lds + AT_K0 + ((t) & 1) * 16384, Kb + (size_t)(t) * 64 * 1024, wave, lane); at_stage(F.lds + AT_V0 + ((t) & 1) * 16384, Vb + (size_t)(t) * 64 * 1024, wave, lane); } } while (0)
    SB_STAGE(T_hi);
    VM_WAIT(); __syncthreads();
    const float C2 = 0.08838834764831845f * 1.4426950408889634f;
    for (int T = T_hi; T >= 0; --T) {
        if (T > 0) SB_STAGE(T - 1);
        const int wq_max = U.q_pos0 + 32 * wave + 31;
        if (!done && 64 * T < wq_max) {
            const LAS unsigned char* kt = F.lds + AT_K0 + (T & 1) * 16384; const LAS unsigned char* vt = F.lds + AT_V0 + (T & 1) * 16384;
#pragma unroll
            for (int sub = 1; sub >= 0; --sub) {
                if (64 * T + 32 * sub >= wq_max) continue;
                f32x16 p = at_qk(kt, ko, sub, qf);
                const int kb0 = 64 * T + 32 * sub + 4 * hi;
                float x[16], zl[16];
#pragma unroll
                for (int r = 0; r < 16; ++r) { const int kp = kb0 + (r & 3) + 8 * (r >> 2); const bool ok = kp < qpos;
                    const float z = p[r] * C2; zl[r] = ok ? z : -__builtin_inff();
                    const float sp = fmaxf(z, 0.f) + __builtin_amdgcn_logf(1.f + __builtin_amdgcn_exp2f(-fabsf(z)));
                    x[r] = ok ? -sp : 0.f; }
                float S[4], Tq[4];
#pragma unroll
                for (int g = 0; g < 4; ++g) { S[g] = (x[4 * g] + x[4 * g + 1]) + (x[4 * g + 2] + x[4 * g + 3]); Tq[g] = xhalf(S[g]); }
                float B = 0.f, ga[4];
#pragma unroll
                for (int g = 3; g >= 0; --g) { ga[g] = B + (hi ? 0.f : Tq[g]); B += S[g] + Tq[g]; }
#pragma unroll
                for (int g = 0; g < 4; ++g) { float run = ga[g] + carry;
#pragma unroll
                    for (int i = 3; i >= 0; --i) { const int r = 4 * g + i; const float aft = run; run += x[r];
                        p[r] = __builtin_amdgcn_exp2f(zl[r] + x[r] + aft); } }
                carry += B;
                at_pv(o, vt, vo, sub, p);
            }
            done = __all(carry < -150.f);
        }
        if (lane == 0) flags[(T & 1) * 8 + wave] = done ? 0u : 1u;
        VM_WAIT(); __syncthreads();
        unsigned any = 0;
#pragma unroll
        for (int w = 0; w < 8; ++w) any |= flags[(T & 1) * 8 + w];
        if (!any) break;
    }
#undef SB_STAGE
    if (haveq) at_store_o(o, 1.f, (bf16*)(F.ws + WS_OSB), tok, U.head, lane);
    __syncthreads();
}

__device__ __forceinline__ int t5_bucket(int rel) {
    const int n = rel < 0 ? -rel : rel;
    const int large = 8 + (n >= 15) + (n >= 27) + (n >= 50) + (n >= 91) + (n >= 166) + (n >= 305) + (n >= 559);
    return (rel > 0 ? 16 : 0) + (n < 8 ? n : large);
}
__device__ __forceinline__ void at_stage_mask(LAS unsigned char* dst, const unsigned* mblk, int mpitch, int T, int nq, int tid, int wave) {
    const int q = (tid >> 1) < nq ? (tid >> 1) : 0;
    __builtin_amdgcn_global_load_lds(mblk + (size_t)q * mpitch + 2 * T + (tid & 1), (LAS unsigned*)(dst + wave * 256), 4, 0, 0);
}
template <int MMODE> __device__ __forceinline__ void dsa_unit(Frame& F, const AttnUnit& U, const unsigned* mblk  , int mpitch, bf16* Oout) {
    const bf16* Kb = (const bf16*)(F.ws + WS_KSA) + (size_t)U.kv_base * 1024 + U.head * 128;
    const bf16* Vb = (const bf16*)(F.ws + WS_VSA) + (size_t)U.kv_base * 1024 + U.head * 128;
    bf16* QO = (bf16*)(F.ws + WS_QSA);
    const int lane = F.lane, wave = F.wave, ql = lane & 31, hi = lane >> 5;
    const bool haveq = wave < U.nqw;
    const int wv = haveq ? wave : 0;
    const int tok = U.q_tok0 + 32 * wv + ql, qpos = U.q_pos0 + 32 * wv + ql;
    const int lim_w = haveq ? (((U.q_pos0 + 32 * wv) >> 6) + 1) * 64 : 0;
    const int T_end = (((U.q_pos0 + 32 * U.nqw - 1) >> 6) + 1);
    int ko[8], vo[4][2]; at_koffs(lane, ko); at_voffs(lane, vo);
    bf16x8 qf[8]; at_load_q(qf, QO, tok, U.head, lane);
    f32x16 o[4];
#pragma unroll
    for (int mt = 0; mt < 4; ++mt)
#pragma unroll
        for (int r = 0; r < 16; ++r) o[mt][r] = 0.f;
    float m2 = -1e30f, l = 0.f;
    unsigned dbg_chk = 0u;
    LAS float* tab = (LAS float*)(F.lds + DS_TAB);
    if (F.tid < 32) tab[F.tid] = F.in[I_REL][F.tid * 8 + U.head] * 1.4426950408889634f;
    LAS float* tabn = (LAS float*)(F.lds + DS_TABN);
    for (int i = F.tid; i < DS_TABN_N; i += NWAVES * 64) tabn[i] = F.in[I_REL][t5_bucket(i - DS_TABN_OFF) * 8 + U.head] * 1.4426950408889634f;
#define DS_STAGE(t) do { at_stage(F.lds + DS_K0 + ((t) & 3) * 16384, Kb + (size_t)(t) * 64 * 1024, wave, lane); at_stage(F.lds + DS_V0 + ((t) & 3) * 16384, Vb + (size_t)(t) * 64 * 1024, wave, lane); \
        at_stage_mask(F.lds + DS_MASK + ((t) & 3) * 2048, mblk, mpitch, (t), 32 * U.nqw, F.tid, wave); } while (0)
    DS_STAGE(0); if (T_end > 1) DS_STAGE(1); if (T_end > 2) DS_STAGE(2);
    if (T_end > 2) asm volatile("s_waitcnt vmcnt(10)" ::: "memory"); else if (T_end > 1) asm volatile("s_waitcnt vmcnt(5)" ::: "memory"); else asm volatile("s_waitcnt vmcnt(0)" ::: "memory");
    asm volatile("s_waitcnt lgkmcnt(0)" ::: "memory"); __builtin_amdgcn_s_barrier(); asm volatile("" ::: "memory");
    const float tabl = tab[ql];
    const float b15 = tab[15];
    const float C2 = 0.08838834764831845f * 1.4426950408889634f;
    for (int T = 0; T < T_end; ++T) {
        if (T + 3 < T_end) DS_STAGE(T + 3);
        if (64 * T < lim_w) {
            const LAS unsigned char* kt = F.lds + DS_K0 + (T & 3) * 16384; const LAS unsigned char* vt = F.lds + DS_V0 + (T & 3) * 16384;
            const v2u mw = MMODE == 1 ? (v2u){0xffffffffu, 0xffffffffu} : *(const LAS v2u*)(F.lds + DS_MASK + (T & 3) * 2048 + (32 * wv + ql) * 8);
            const bool far = (64 * T + 63) <= (U.q_pos0 + 32 * wv) - 559;
#pragma unroll
            for (int sub = 0; sub < 2; ++sub) {
                const unsigned wbits = (sub ? mw.y : mw.x) >> (4 * hi);
                f32x16 p = at_qk(kt, ko, sub, qf);
                if (far) {
                    const bool has = m2 > -1e29f; const float bm = b15 - (has ? m2 : 0.f);
                    float xm[16], umax;
#pragma unroll
                    for (int r = 0; r < 16; ++r) xm[r] = fmaf(p[r], C2, bm);
                    umax = xm[0];
#pragma unroll
                    for (int r = 1; r < 16; ++r) umax = fmaxf(umax, xm[r]);
                    umax = fmaxf(umax, xhalf(umax));
                    const unsigned wsel = wbits & 0x0f0f0f0fu, wany = wsel | (unsigned)__shfl_xor((int)wsel, 32);
                    unsigned pw[8];
#pragma unroll
                    for (int k = 0; k < 8; ++k) { const int c0 = 2 * (k & 1) + 8 * (k >> 1);
                        const unsigned mlo = (unsigned)__builtin_amdgcn_sbfe((int)wbits, c0, 1), mhi = (unsigned)__builtin_amdgcn_sbfe((int)wbits, c0 + 1, 1);
                        pw[k] = pk2(__builtin_amdgcn_exp2f(xm[2 * k]), __builtin_amdgcn_exp2f(xm[2 * k + 1])) & __builtin_amdgcn_perm(mhi, mlo, 0x05040100u); }
                    if (!__any(umax > 8.f || (!has && wany != 0u))) {
#pragma unroll
                        for (int k = 0; k < 8; ++k) l = __builtin_amdgcn_fdot2_f32_bf16(__builtin_bit_cast(bf16x2_, pw[k]), __builtin_bit_cast(bf16x2_, 0x3f803f80u), l, false);
                        at_pv_w(o, vt, vo, sub, pw);
                        continue;
                    }
                }
                float pmax = -__builtin_inff();
                if (far) {
#pragma unroll
                    for (int r = 0; r < 16; ++r) { const bool sel = (wbits >> ((r & 3) + 8 * (r >> 2))) & 1u; p[r] = sel ? fmaf(p[r], C2, b15) : -__builtin_inff(); pmax = fmaxf(pmax, p[r]); }
                } else {
                    int ti = 64 * T + 32 * sub + 4 * hi - qpos + DS_TABN_OFF; ti = ti < 0 ? 0 : (ti > DS_TABN_N - 28 ? DS_TABN_N - 28 : ti);
                    const LAS float* tb = tabn + ti;
#pragma unroll
                    for (int r = 0; r < 16; ++r) { const bool sel = (wbits >> ((r & 3) + 8 * (r >> 2))) & 1u;
                        const float bias = tb[(r & 3) + 8 * (r >> 2)];
                        p[r] = sel ? fmaf(p[r], C2, bias) : -__builtin_inff(); pmax = fmaxf(pmax, p[r]); }
                }
                pmax = fmaxf(pmax, xhalf(pmax));
                if (!__all(pmax - m2 <= 8.f)) {
                    const float mn = fmaxf(m2, pmax), alpha = __builtin_amdgcn_exp2f(m2 - mn);
#pragma unroll
                    for (int mt = 0; mt < 4; ++mt)
#pragma unroll
                        for (int r = 0; r < 16; ++r) o[mt][r] *= alpha;
                    l *= alpha; m2 = mn;
                }
                float ps = 0.f;
#pragma unroll
                for (int r = 0; r < 16; ++r) { p[r] = __builtin_amdgcn_exp2f(p[r] - m2); ps += p[r]; }
                l += ps;
                at_pv(o, vt, vo, sub, p);
            }
        }
        { const int after = T_end - 2 - T;
          if (after >= 2) asm volatile("s_waitcnt vmcnt(10)" ::: "memory"); else if (after == 1) asm volatile("s_waitcnt vmcnt(5)" ::: "memory"); else asm volatile("s_waitcnt vmcnt(0)" ::: "memory"); }
        asm volatile("s_waitcnt lgkmcnt(0)" ::: "memory"); __builtin_amdgcn_s_barrier(); asm volatile("" ::: "memory");
    }
#undef DS_STAGE
    const float lt = l + xhalf(l);
    if (haveq) at_store_o(o, lt > 0.f ? 1.f / lt : 0.f, Oout, tok, U.head, lane);
    __syncthreads();
}
typedef float f32x2i __attribute__((ext_vector_type(2)));
typedef int i32x16i __attribute__((ext_vector_type(16)));
constexpr int IX_CAP = 512, IX_BITS = 131072;
__device__ __forceinline__ unsigned f2key(float f) { const unsigned u = __float_as_uint(f); return u ^ ((unsigned)((int)u >> 31) | 0x80000000u); }
__device__ __forceinline__ int ix_select(LAS unsigned* bk, LAS unsigned short* bi, int n, int nbits, int lane, unsigned& bound_out) {
    unsigned key[8]; unsigned idx[8];
#pragma unroll
    for (int i = 0; i < 8; ++i) { const int e = lane + 64 * i; const bool v = e < n; key[i] = v ? bk[e] : 0u; idx[i] = v ? (unsigned)bi[e] : 0u; }
    unsigned prefix = 0u;
    for (int bit = 31; bit >= 32 - nbits; --bit) { const unsigned cand = prefix | (1u << bit); int c = 0;
#pragma unroll
        for (int i = 0; i < 8; ++i) c += __popcll(__ballot(key[i] >= cand));
        if (c >= 256) prefix = cand; }
    const unsigned long long lt = (1ull << lane) - 1ull;
    bool keep[8];
    if (nbits == 32) {
        int ngt = 0;
#pragma unroll
        for (int i = 0; i < 8; ++i) ngt += __popcll(__ballot(key[i] > prefix));
        const int need = 256 - ngt; int eqbase = 0;
#pragma unroll
        for (int i = 0; i < 8; ++i) { const bool eq = (key[i] == prefix) && (key[i] != 0u); const unsigned long long m = __ballot(eq);
            const int rank = eqbase + __popcll(m & lt); keep[i] = (key[i] > prefix) || (eq && rank < need); eqbase += __popcll(m); }
        bound_out = prefix;
    } else {
#pragma unroll
        for (int i = 0; i < 8; ++i) keep[i] = (key[i] >= prefix) && (key[i] != 0u);
        bound_out = prefix - 1u;
    }
    int base = 0;
#pragma unroll
    for (int i = 0; i < 8; ++i) { const unsigned long long m = __ballot(keep[i]); const int pos = base + __popcll(m & lt);
        if (keep[i]) { bk[pos] = key[i]; bi[pos] = (unsigned short)idx[i]; } base += __popcll(m); }
    return base;
}
struct CvState { f32x4 a, b; int k; };
__device__ __forceinline__ bool cv_step(Frame& F, CvState& cv) {
    const size_t NGT = (size_t)F.G * (NWAVES * 64), gt = (size_t)F.c * (NWAVES * 64) + F.tid; const int KT = (int)(((size_t)8388608 + NGT - 1) / NGT);
    if (cv.k > 2 * KT) return false;
    if (cv.k > 0) { const int kk = cv.k - 1; const bool t = kk >= KT; const size_t i = gt + (size_t)(t ? kk - KT : kk) * NGT;
        if (i < (size_t)8388608) { const size_t e = i * 8, sq = e >> 21, rem = e & 2097151;
            v4u o; o.x = pk2(cv.a[0], cv.a[1]); o.y = pk2(cv.a[2], cv.a[3]); o.z = pk2(cv.b[0], cv.b[1]); o.w = pk2(cv.b[2], cv.b[3]);
            __builtin_nontemporal_store(o, (v4u*)((bf16*)(F.ws + (t ? WS_VSA : WS_KSA)) + ((size_t)MP + sq * SKV) * 1024 + rem)); } }
    if (cv.k < 2 * KT) { const int kk = cv.k; const bool t = kk >= KT; const size_t i = gt + (size_t)(t ? kk - KT : kk) * NGT;
        if (i < (size_t)8388608) { const float* src = (t ? F.in[I_CSAV] : F.in[I_CSAK]) + i * 8; cv.a = *(const GAS f32x4*)src; cv.b = *(const GAS f32x4*)(src + 4); } }
    ++cv.k;
    return true;
}
__device__ __forceinline__ void ix_unit(Frame& F, int kv_base, int q_tok0, int lim, unsigned* mask0, int mpitch, CvState& cv) {
    const int lane = F.lane, wave = F.wave, kl = lane & 31, hh = lane >> 5;
    const bf16* QIX = (const bf16*)(F.ws + WS_QIX); const float* WIX = (const float*)(F.ws + WS_WIX);
    const bf16* kp = (const bf16*)(F.ws + WS_KIX) + (size_t)kv_base * 64 + kl * 64 + 8 * hh;
    bf16x8 qa[2][4]; float wvv[2][16];
#pragma unroll
    for (int p = 0; p < 2; ++p) {
        const int g = kl >> 3, h1 = (kl >> 2) & 1, i = kl & 3;
        const bf16* qp = QIX + (size_t)(q_tok0 + 4 * wave + 2 * p + h1) * 1024 + (4 * g + i) * 64 + 8 * hh;
#pragma unroll
        for (int ks = 0; ks < 4; ++ks) qa[p][ks] = *(const GAS bf16x8*)(qp + 16 * ks);
        const float* wp = WIX + (size_t)(q_tok0 + 4 * wave + 2 * p + hh) * 16;
#pragma unroll
        for (int r4 = 0; r4 < 4; ++r4) { const f32x4 w4 = *(const GAS f32x4*)(wp + 4 * r4);
#pragma unroll
            for (int j = 0; j < 4; ++j) wvv[p][4 * r4 + j] = w4[j] * 0.03125f; }
    }
    int cnt0 = 0, cnt1 = 0, cnt2 = 0, cnt3 = 0; unsigned bound[2] = {0u, 0u};
    LAS unsigned char* wb = F.lds + wave * 12288;
    const int nsubs = lim >> 5;
#define IX_LD(KB, SUB) do { _Pragma("unroll") for (int ks_ = 0; ks_ < 4; ++ks_) KB[ks_] = *(const GAS bf16x8*)(kp + (size_t)(SUB) * 2048 + 16 * ks_); } while (0)
#define IX_MF(dst, P, KB) do { _Pragma("unroll") for (int r_ = 0; r_ < 16; ++r_) dst[r_] = 0.f; _Pragma("unroll") for (int ks_ = 0; ks_ < 4; ++ks_) dst = MFMA32(qa[P][ks_], KB[ks_], dst); } while (0)
#define IX_PROC(A, P, SUB) do { float s_; { i32x16i iv_ = __builtin_bit_cast(i32x16i, A); i32x16i zz_; _Pragma("unroll") for (int r_ = 0; r_ < 16; ++r_) zz_[r_] = 0; \
            iv_ = __builtin_elementwise_max(iv_, zz_); const f32x16 rl_ = __builtin_bit_cast(f32x16, iv_); f32x2i s2_ = {0.f, 0.f}; \
            _Pragma("unroll") for (int r_ = 0; r_ < 16; r_ += 2) { const f32x2i x_ = {rl_[r_], rl_[r_ + 1]}; const f32x2i w2_ = {wvv[P][r_], wvv[P][r_ + 1]}; s2_ = w2_ * x_ + s2_; } s_ = s2_.x + s2_.y; } \
        const unsigned kpos_ = (unsigned)(32 * (SUB) + kl); const unsigned key_ = f2key(s_); const bool pass_ = key_ > bound[P]; const unsigned long long m_ = __ballot(pass_); \
        if (m_) { const unsigned mlo_ = (unsigned)m_, mhi_ = (unsigned)(m_ >> 32); int& cA_ = (P == 0 ? cnt0 : cnt2); int& cB_ = (P == 0 ? cnt1 : cnt3); \
            const int nlo_ = __popc(mlo_), below_ = (int)__builtin_amdgcn_mbcnt_hi(mhi_, __builtin_amdgcn_mbcnt_lo(mlo_, 0u));     \
            const int pos_ = (hh ? cB_ - nlo_ : cA_) + below_; LAS unsigned char* qb_ = wb + (2 * P + hh) * 3072; \
            if (pass_) { ((LAS unsigned*)qb_)[pos_] = key_; ((LAS unsigned short*)(qb_ + 2048))[pos_] = (unsigned short)kpos_; } \
            cA_ += nlo_; cB_ += __popc(mhi_); \
            if ((cA_ > cB_ ? cA_ : cB_) > IX_CAP - 32) { \
            if (cA_ > IX_CAP - 32) { unsigned b_; LAS unsigned char* q0_ = wb + (2 * P) * 3072; cA_ = ix_select((LAS unsigned*)q0_, (LAS unsigned short*)(q0_ + 2048), cA_, 12, lane, b_); \
                if (cA_ > 384) cA_ = ix_select((LAS unsigned*)q0_, (LAS unsigned short*)(q0_ + 2048), cA_, 32, lane, b_); if (!hh) bound[P] = b_; } \
            if (cB_ > IX_CAP - 32) { unsigned b_; LAS unsigned char* q1_ = wb + (2 * P + 1) * 3072; cB_ = ix_select((LAS unsigned*)q1_, (LAS unsigned short*)(q1_ + 2048), cB_, 12, lane, b_); \
                if (cB_ > 384) cB_ = ix_select((LAS unsigned*)q1_, (LAS unsigned short*)(q1_ + 2048), cB_, 32, lane, b_); if (hh) bound[P] = b_; } } } } while (0)
#define IX_STEP(KCUR, KFILL, SUB) do { IX_LD(KFILL, (SUB) + 1);          \
        f32x16 a0_, a1_; IX_MF(a0_, 0, KCUR); IX_MF(a1_, 1, KCUR); IX_PROC(a0_, 0, SUB); IX_PROC(a1_, 1, SUB); } while (0)
    bf16x8 kA[4], kB[4];
    IX_LD(kA, 0);
    for (int sub = 0; sub < nsubs; sub += 2) { IX_STEP(kA, kB, sub); IX_STEP(kB, kA, sub + 1); if ((sub & 2) == 0) cv_step(F, cv); }
#undef IX_STEP
#undef IX_LD
#undef IX_MF
#undef IX_PROC
    LAS unsigned* bits = (LAS unsigned*)(F.lds + IX_BITS + wave * 2048);
    const int nw = lim >> 5;
#pragma unroll 1
    for (int q4 = 0; q4 < 4; ++q4) {
        int n = q4 == 0 ? cnt0 : q4 == 1 ? cnt1 : q4 == 2 ? cnt2 : cnt3;
        LAS unsigned char* qb = wb + q4 * 3072; unsigned b;
        if (n > 256) n = ix_select((LAS unsigned*)qb, (LAS unsigned short*)(qb + 2048), n, 32, lane, b);
        for (int w = lane; w < nw; w += 64) bits[w] = 0u;
        for (int e = lane; e < n; e += 64) { const unsigned ix = ((LAS unsigned short*)(qb + 2048))[e]; __hip_atomic_fetch_or(bits + (ix >> 5), 1u << (ix & 31), __ATOMIC_RELAXED, __HIP_MEMORY_SCOPE_WORKGROUP); }
        unsigned* mr = mask0 + (size_t)(4 * wave + q4) * mpitch;
        for (int w = lane; w < nw; w += 64) mr[w] = bits[w];
    }
}
constexpr int N_PHASES = 12;
struct Args { const float* in[25]; float* out; unsigned char* ws; int ph_lo, ph_hi; };
__global__ void __launch_bounds__(NWAVES * 64, 2) fwd_kernel(Args args) {
    extern __shared__ __attribute__((aligned(16))) unsigned char lds[];
    Frame F;
    F.lds = (LAS unsigned char*)lds; F.ws = args.ws; F.out = args.out;
    F.tid = threadIdx.x; F.lane = F.tid & 63; F.wave = __builtin_amdgcn_readfirstlane(F.tid >> 6);
    F.G = gridDim.x; F.c = blockIdx.x;
#pragma unroll
    for (int i = 0; i < 25; ++i) F.in[i] = args.in[i];
    volatile LAS unsigned* MISC = (volatile LAS unsigned*)(F.lds + MISC_OFF);
    if (F.tid < 64) MISC[F.tid] = 0u;
    __syncthreads();
    unsigned* ctl = (unsigned*)(F.ws + WS_CTL);
    XcdBarrier bar; bar.bar = ctl + CW_BAR; bar.x = 0; bar.st = nullptr;
    const int lo = args.ph_lo, hi = args.ph_hi;
    const bool one_launch = (hi - lo) > 1;
    if (one_launch) bar = xcd_barrier_post(ctl + CW_BAR, MISC + 8);
#define IN(k) (lo <= (k) && (k) < hi)
#define SEAM(k) do { if (IN(k) && IN((k) + 1)) xcd_barrier(bar); } while (0)

    if (IN(0)) { p0_prologue(F); } SEAM(0);
    if (IN(1)) { norm_mod_rows(F, F.in[I_XP], F.in[I_XS], F.in[I_GMIX], 0, 1, 0, MT, F.c, F.G); } SEAM(1);
    if (IN(2)) {
      {
        pg8::Gemm g{(const bf16*)(F.ws + WS_HB), (const bf16*)(F.ws + WS_WCAT), MT, NCAT, DM}; pg8::StaticOrder S; S.init(MT, NCAT, F.G, F.c);
        pg8::EpiG1 E{F.ws, F.out};
        pg8::gemm_phase<pg8::EpiG1, pg8::StaticOrder, true, true>(F.lds + RING_OFF, g, S, E);
      }
    } SEAM(2);
    if (IN(3)) {
      {
        CvState cv; cv.k = 0; cv.a = (f32x4){0.f, 0.f, 0.f, 0.f}; cv.b = cv.a;
        const int sb_n = (F.G == 256) ? (F.c < 64 ? 2 : 6) : 0, sb_0 = (F.G == 256) ? (F.c < 64 ? 2 * F.c : 128 + 6 * (F.c - 64)) : F.c;
        for (int u = sb_0, k_ = 0; u < 1280 && (F.G != 256 || k_ < sb_n); u += (F.G == 256 ? 1 : F.G), ++k_) {
            AttnUnit U;
            if (u < 1024) { const int b = u >> 9, qb = u & 63; U.kv_base = b * SEQ; U.q_tok0 = b * SEQ + 256 * qb; U.q_pos0 = 256 * qb; U.nqw = 8; U.head = (u >> 6) & 7; U.ck = nullptr; U.cv = nullptr; }
            else { const int v = u - 1024, s = v >> 3; U.kv_base = MP + s * SKV; U.q_tok0 = MP + 64 * s; U.q_pos0 = PAST; U.nqw = 2; U.head = v & 7;
                   U.ck = F.in[I_CSBK] + (size_t)s * PAST * 1024; U.cv = F.in[I_CSBV] + (size_t)s * PAST * 1024; }
            sb_unit(F, U);
        }
        for (int j = F.c; j < 512; j += F.G) {
            const int b = j >> 8, jj = j & 255;
#pragma unroll 1
            for (int k = 0; k < 2; ++k) { const int hc = k ? 511 - jj : jj, q0 = 32 * hc;
                ix_unit(F, b * SEQ, b * SEQ + q0, 64 * ((hc >> 1) + 1), (unsigned*)(F.ws + WS_MASKP) + (size_t)(b * SEQ + q0) * MASKP_PITCH, MASKP_PITCH, cv); }
        }
        for (int v = F.c; v < 64; v += F.G) { const int s = v >> 1, half = v & 1;
            ix_unit(F, MP + s * SKV, MP + 64 * s + 32 * half, SKV, (unsigned*)(F.ws + WS_MASKS) + (size_t)(64 * s + 32 * half) * MASKS_PITCH, MASKS_PITCH, cv); }
        for (int g_ = 0; g_ < 65536; ++g_) if (!cv_step(F, cv)) break;
      }
    } SEAM(3);
    if (IN(4)) {
      {
        for (int it = F.c; it < 512; it += F.G) {
            const int pu = (F.G == 256) ? ((2 * (it & 7) + (it >> 8)) << 5) + ((it >> 3) & 31) : it;
            const int b = pu >> 8, i = pu & 31;
#pragma unroll 1
            for (int k = 0; k < 2; ++k) { const int qb = k ? 63 - i : i;
                AttnUnit U; U.kv_base = b * SEQ; U.q_tok0 = b * SEQ + 256 * qb; U.q_pos0 = 256 * qb; U.nqw = 8; U.head = (pu >> 5) & 7; U.ck = nullptr; U.cv = nullptr;
                dsa_unit<0>(F, U, (const unsigned*)(F.ws + WS_MASKP) + (size_t)(b * SEQ + 256 * qb) * MASKP_PITCH, MASKP_PITCH, (bf16*)(F.ws + WS_OSA)); }
        }
        for (int v = F.c; v < 256; v += F.G) { const int s = v >> 3;
            AttnUnit U; U.kv_base = MP + s * SKV; U.q_tok0 = MP + 64 * s; U.q_pos0 = PAST; U.nqw = 2; U.head = v & 7; U.ck = nullptr; U.cv = nullptr;
            dsa_unit<0>(F, U, (const unsigned*)(F.ws + WS_MASKS) + (size_t)(64 * s) * MASKS_PITCH, MASKS_PITCH, (bf16*)(F.ws + WS_OSA)); }
      }
    } SEAM(4);
    if (IN(5)) {
      {
        { pg8::Gemm g{(const bf16*)(F.ws + WS_OSB), (const bf16*)(F.ws + WS_WBRSB), MT, DM, WSB}; pg8::StaticOrder S; S.init(MT, DM, F.G, F.c);
          pg8::EpiBr1 E{F.ws}; pg8::gemm_phase<pg8::EpiBr1, pg8::StaticOrder, true, true>(F.lds + RING_OFF, g, S, E); }
        VM_WAIT(); __syncthreads();
        { pg8::Gemm g{(const bf16*)(F.ws + WS_OSA), (const bf16*)(F.ws + WS_WBRSA), MT, DM, WSB}; pg8::StaticOrder S; S.init(MT, DM, F.G, F.c);
          pg8::EpiBr2 E{F.ws}; pg8::gemm_phase<pg8::EpiBr2, pg8::StaticOrder, true, true>(F.lds + RING_OFF, g, S, E); }
      }
    } SEAM(5);
    const bool split = one_launch && F.G > 64;
    constexpr int P7_EARLY = MP;
    if (IN(6)) {
      {
        pg8::Gemm g{(const bf16*)(F.ws + WS_MRG), (const bf16*)(F.ws + WS_WOUT), MT, DM, DM};
        pg8::EpiRes E{F.in[I_XP], F.in[I_XS], (float*)(F.ws + WS_XMID), (const float*)(F.ws + WS_MOD), 2};
        { pg8::StaticOrder S; S.init(split ? MP : MT, DM, F.G, F.c); pg8::gemm_phase<pg8::EpiRes, pg8::StaticOrder, true, true>(F.lds + RING_OFF, g, S, E); }
        if (split) {
            VM_WAIT(); __syncthreads();
            if (F.tid == 0) xcd_count_in(bar, ctl + CW_P6L, ctl + CW_P6);
            if (F.c < 64) { pg8::TailOrder S{MP / 256, DM / 256, F.c}; pg8::gemm_phase<pg8::EpiRes, pg8::TailOrder, true, true>(F.lds + RING_OFF, g, S, E); }
            else {
                if (F.tid == 0) { XB_SPIN(xb_ld(ctl + CW_P6) < (unsigned)F.G, bar.bar); __builtin_amdgcn_fence(__ATOMIC_ACQUIRE, "agent"); VM_WAIT(); }
                __syncthreads();
                norm_mod_rows(F, (const float*)(F.ws + WS_XMID), (const float*)(F.ws + WS_XMID) + (size_t)MP * DM, F.in[I_GFFN], 3, 4, 0, P7_EARLY, F.c - 64, F.G - 64);
            }
        }
      }
    } SEAM(6);
    if (IN(7)) { norm_mod_rows(F, (const float*)(F.ws + WS_XMID), (const float*)(F.ws + WS_XMID) + (size_t)MP * DM, F.in[I_GFFN], 3, 4, split ? P7_EARLY : 0, MT, F.c, F.G); } SEAM(7);
    if (IN(8)) {
      {
        pg8::Gemm g{(const bf16*)(F.ws + WS_HB), (const bf16*)(F.ws + WS_WUP), MT, NUP, DM}; pg8::StaticOrder S; S.init(MT, NUP, F.G, F.c);
        pg8::EpiUpConv E{F.ws, F.out, F.in[I_CONVW], F.in[I_CONVB], F.in[I_CONVST], (LAS float*)(F.lds + HALO_OFF)};
        pg8::gemm_phase<pg8::EpiUpConv, pg8::StaticOrder, true, true>(F.lds + RING_OFF, g, S, E);
      }
    } SEAM(8);
    if (IN(9)) { conv_fix(F); } SEAM(9);
    if (IN(10)) {
      {
        pg8::Gemm g{(const bf16*)(F.ws + WS_ACT), (const bf16*)(F.ws + WS_WDOWN), MT, DM, DFF};
        pg8::EpiRes E{(const float*)(F.ws + WS_XMID), (const float*)(F.ws + WS_XMID) + (size_t)MP * DM, F.out + O_Y, (const float*)(F.ws + WS_MOD), 5};
        { pg8::StaticOrder S; S.init(split ? MP : MT, DM, F.G, F.c); pg8::gemm_phase<pg8::EpiRes, pg8::StaticOrder, true, true>(F.lds + RING_OFF, g, S, E); }
        if (split) {
            VM_WAIT(); __syncthreads();
            if (F.tid == 0) xcd_count_in(bar, ctl + CW_P10L, ctl + CW_P10);
            if (F.c < 64) { pg8::TailOrder S{MP / 256, DM / 256, F.c}; pg8::gemm_phase<pg8::EpiRes, pg8::TailOrder, true, true>(F.lds + RING_OFF, g, S, E); }
            else {
                if (F.tid == 0) { XB_SPIN(xb_ld(ctl + CW_P10) < (unsigned)F.G, bar.bar); __builtin_amdgcn_fence(__ATOMIC_ACQUIRE, "agent"); VM_WAIT(); }
                __syncthreads();
                final_norm_rows(F, 0, MP, F.c - 64, F.G - 64);
            }
        }
      }
    } SEAM(10);
    if (IN(11)) { final_norm_rows(F, split ? MP : 0, MT, F.c, F.G); }
#undef IN
#undef SEAM
}

extern "C" void kernel_launch(void* const* d_in, const int* in_sizes, int n_in, void* d_out, int out_size, void* d_ws, size_t ws_size, hipStream_t stream) {
    static int grid = 0;
    if (grid == 0) {
        if (n_in != 25 || in_sizes[0] != MP * DM || (size_t)out_size != O_END || ws_size < WS_END) {
            fprintf(stderr, "kernel_launch: built for 25 inputs, out of %zu floats, >= %zu bytes of workspace; got n_in %d, in0 %d, out %d, ws %zu; nothing launched\n", (size_t)O_END, (size_t)WS_END, n_in, n_in > 0 ? in_sizes[0] : -1, out_size, ws_size); grid = -1; return; }
        int dev = 0, cus = 0, per_cu = 0;
        if (hipGetDevice(&dev) != hipSuccess || hipDeviceGetAttribute(&cus, hipDeviceAttributeMultiprocessorCount, dev) != hipSuccess) { fprintf(stderr, "kernel_launch: device query failed\n"); grid = -1; return; }
        if (hipFuncSetAttribute((const void*)fwd_kernel, hipFuncAttributeMaxDynamicSharedMemorySize, LDS_BYTES) != hipSuccess) { fprintf(stderr, "kernel_launch: hipFuncSetAttribute failed\n"); grid = -1; return; }
        if (hipOccupancyMaxActiveBlocksPerMultiprocessor(&per_cu, (const void*)fwd_kernel, NWAVES * 64, LDS_BYTES) != hipSuccess || per_cu < 1)
            fprintf(stderr, "kernel_launch: note: occupancy query reports %d workgroups per CU\n", per_cu);
        (void)hipGetLastError();
        grid = cus;
    }
    if (grid < 0) return;
    if (hipMemsetAsync((char*)d_ws + WS_CTL, 0, CTL_ZERO_BYTES, stream) != hipSuccess) { fprintf(stderr, "kernel_launch: memset failed\n"); return; }
    Args a{};
    for (int i = 0; i < 25; ++i) a.in[i] = (const float*)d_in[i];
    a.out = (float*)d_out; a.ws = (unsigned char*)d_ws;
    a.ph_lo = 0; a.ph_hi = N_PHASES;
    hipLaunchKernelGGL(fwd_kernel, dim3(grid), dim3(NWAVES * 64), LDS_BYTES, stream, a);
    const hipError_t le = hipPeekAtLastError();
    if (le != hipSuccess) fprintf(stderr, "kernel_launch: launch failed: %s\n", hipGetErrorName(le));
}
```
